# Optimizing an MI355X kernel written in HIP

```python
import math
import jax, jax.numpy as jnp
from jax import lax
import numpy as np

D_MODEL = 1024
BATCH = 8
SEQ = 2048
DEPTH = 4

N_A = DEPTH // 2
N_B = DEPTH - N_A
POOL_WINDOWS = (2, 4, 8, 16)
N_GROUPS = len(POOL_WINDOWS)
GROUP_DIM = D_MODEL // N_GROUPS
N_HEADS = 8
HEAD_DIM = D_MODEL // (2 * N_HEADS)
V_DIM = 2 * HEAD_DIM
QK_WIDTH = N_HEADS * 2 * HEAD_DIM
V_WIDTH = N_HEADS * V_DIM
D_FF = 4 * D_MODEL
N_BUCKETS = 32
MAX_DISTANCE = 128
Q_BLOCK = 128
EPS = 1e-6

kernel_name = "yoco_pool_diffattn_hybrid"


def _rmsnorm(x, g):
    xf = x.astype(jnp.float32)
    y = xf * lax.rsqrt(jnp.mean(xf * xf, axis=-1, keepdims=True) + EPS)
    return (y * g.astype(jnp.float32)).astype(x.dtype)


def _t5_bucket(rel):
    n = jnp.maximum(rel, 0)
    max_exact = N_BUCKETS // 2
    is_small = n < max_exact
    nf = jnp.maximum(n, 1).astype(jnp.float32)
    large = max_exact + (jnp.log(nf / max_exact) / math.log(MAX_DISTANCE / max_exact)
                         * (N_BUCKETS - max_exact)).astype(jnp.int32)
    large = jnp.minimum(large, N_BUCKETS - 1)
    return jnp.where(is_small, n, large)


def _pool_mixer(h, pool_w, pool_scale):
    b, s, _ = h.shape
    hg = h.reshape(b, s, N_GROUPS, GROUP_DIM).astype(jnp.float32)
    c = jnp.cumsum(hg, axis=1)
    c = jnp.concatenate([jnp.zeros((b, 1, N_GROUPS, GROUP_DIM), jnp.float32), c], axis=1)
    t = jnp.arange(s)
    outs = []
    for g, w in enumerate(POOL_WINDOWS):
        lo = jnp.maximum(t + 1 - w, 0)
        win_sum = c[:, 1:, g] - c[:, lo, g]
        cnt = (t + 1 - lo).astype(jnp.float32)
        outs.append(win_sum / cnt[None, :, None])
    pooled = jnp.stack(outs, axis=2)
    m = (pooled - hg).astype(h.dtype)
    y = jnp.einsum('bsgc,gcd->bsgd', m, pool_w).reshape(b, s, D_MODEL)
    return y * pool_scale


def _mlp(h, w_in, w_out):
    a = jnp.square(jax.nn.relu(h @ w_in))
    return a @ w_out


def _diff_attn(h, k, v, w_q, q_norm, lam_q1, lam_k1, lam_q2, lam_k2, subln, w_o, rel_bias, lambda_init):
    b, s, _ = h.shape
    q = (h @ w_q).reshape(b, s, N_HEADS, 2, HEAD_DIM)
    q = _rmsnorm(q, q_norm) * (HEAD_DIM ** -0.5)
    lam = (jnp.exp(jnp.sum(lam_q1.astype(jnp.float32) * lam_k1.astype(jnp.float32)))
           - jnp.exp(jnp.sum(lam_q2.astype(jnp.float32) * lam_k2.astype(jnp.float32)))
           + lambda_init)
    nb = s // Q_BLOCK
    qb = q.reshape(b, nb, Q_BLOCK, N_HEADS, 2, HEAD_DIM).transpose(1, 0, 2, 3, 4, 5)
    kpos = jnp.arange(s)

    def block(args):
        i, qi = args
        qpos = i * Q_BLOCK + jnp.arange(Q_BLOCK)
        rel = qpos[:, None] - kpos[None, :]
        bias = rel_bias[_t5_bucket(rel)].astype(jnp.float32).transpose(2, 0, 1)
        sc = jnp.einsum('bqhcd,bkhcd->bhcqk', qi, k).astype(jnp.float32)
        sc = sc + bias[None, :, None]
        sc = jnp.where((rel >= 0)[None, None, None], sc, -jnp.inf)
        p = jax.nn.softmax(sc, axis=-1)
        a = p[:, :, 0] - lam * p[:, :, 1]
        return jnp.einsum('bhqk,bkhe->bqhe', a.astype(v.dtype), v)

    o = lax.map(block, (jnp.arange(nb), qb))
    o = o.transpose(1, 0, 2, 3, 4).reshape(b, s, N_HEADS, V_DIM)
    o = _rmsnorm(o, subln) * (1.0 - lambda_init)
    return o.reshape(b, s, V_WIDTH) @ w_o


def setup_inputs(seed: int = 0) -> dict:
    key = jax.random.key(seed)
    ks = jax.random.split(key, 24)
    f = jnp.float32
    nrm = lambda k, shape, sc: jax.random.normal(k, shape, f) * sc
    return {
        "x": nrm(ks[0], (BATCH, SEQ, D_MODEL), 1.0),
        "norm_mix": 1.0 + nrm(ks[1], (DEPTH, D_MODEL), 0.05),
        "norm_mlp": 1.0 + nrm(ks[2], (DEPTH, D_MODEL), 0.05),
        "pool_w": nrm(ks[3], (N_A, N_GROUPS, GROUP_DIM, GROUP_DIM), GROUP_DIM ** -0.5),
        "pool_scale": 1.0 + nrm(ks[4], (N_A, D_MODEL), 0.05),
        "kv_norm": 1.0 + nrm(ks[5], (D_MODEL,), 0.05),
        "w_kv": nrm(ks[6], (D_MODEL, QK_WIDTH + V_WIDTH), D_MODEL ** -0.5),
        "k_norm": 1.0 + nrm(ks[7], (HEAD_DIM,), 0.05),
        "rel_bias": nrm(ks[8], (N_BUCKETS, N_HEADS), 0.5),
        "w_q": nrm(ks[9], (N_B, D_MODEL, QK_WIDTH), D_MODEL ** -0.5),
        "q_norm": 1.0 + nrm(ks[10], (N_B, HEAD_DIM), 0.05),
        "lam_q1": nrm(ks[11], (N_B, HEAD_DIM), 0.1),
        "lam_k1": nrm(ks[12], (N_B, HEAD_DIM), 0.1),
        "lam_q2": nrm(ks[13], (N_B, HEAD_DIM), 0.1),
        "lam_k2": nrm(ks[14], (N_B, HEAD_DIM), 0.1),
        "subln": 1.0 + nrm(ks[15], (N_B, V_DIM), 0.05),
        "w_o": nrm(ks[16], (N_B, V_WIDTH, D_MODEL), V_WIDTH ** -0.5),
        "w_mlp_in": nrm(ks[17], (DEPTH, D_MODEL, D_FF), D_MODEL ** -0.5),
        "w_mlp_out": nrm(ks[18], (DEPTH, D_FF, D_MODEL), D_FF ** -0.5),
    }


def reference(x, norm_mix, norm_mlp, pool_w, pool_scale, kv_norm, w_kv, k_norm, rel_bias,
              w_q, q_norm, lam_q1, lam_k1, lam_q2, lam_k2, subln, w_o, w_mlp_in, w_mlp_out):
    b, s, _ = x.shape
    k_sh = None
    v_sh = None
    for l in range(DEPTH):
        h = _rmsnorm(x, norm_mix[l])
        if l < N_A:
            x = x + _pool_mixer(h, pool_w[l], pool_scale[l])
        else:
            j = l - N_A
            lambda_init = 0.8 - 0.6 * math.exp(-0.3 * l)
            x = x + _diff_attn(h, k_sh, v_sh, w_q[j], q_norm[j], lam_q1[j], lam_k1[j],
                               lam_q2[j], lam_k2[j], subln[j], w_o[j], rel_bias, lambda_init)
        x = x + _mlp(_rmsnorm(x, norm_mlp[l]), w_mlp_in[l], w_mlp_out[l])
        if l == N_A - 1:
            kv = _rmsnorm(x, kv_norm) @ w_kv
            k_sh = _rmsnorm(kv[..., :QK_WIDTH].reshape(b, s, N_HEADS, 2, HEAD_DIM), k_norm)
            v_sh = kv[..., QK_WIDTH:].reshape(b, s, N_HEADS, V_DIM)
    return x
```

```cpp
#include <hip/hip_runtime.h>
#include <cstdint>
#include <cmath>
#include <cstdio>

typedef unsigned short bf16;
constexpr int BATCH = 8, SEQ = 2048, DM = 1024, M = BATCH * SEQ, FF = 4096, NH = 8, HD = 64, VD = 128;
constexpr float EPS = 1e-6f;
constexpr float LOG2E = 1.4426950408889634f;

__device__ __forceinline__ unsigned f2bf(float f) { unsigned u = __float_as_uint(f); return (u + 0x7fffu + ((u >> 16) & 1u)) >> 16; }
__device__ __forceinline__ float bf2f(unsigned h) { return __uint_as_float(h << 16); }
__device__ __forceinline__ unsigned pk2(float lo, float hi) { return f2bf(lo) | (f2bf(hi) << 16); }

constexpr size_t MiB = 1u << 20;
constexpr size_t WS_CTL = 0, CTL_ZERO_BYTES = 64 * 1024;
constexpr size_t WS_SSQ = MiB / 2, WS_SSQ2 = 3 * MiB / 4;
constexpr size_t WS_WIN = 1 * MiB;
constexpr size_t WS_WOUT = 9 * MiB;
constexpr size_t WS_WQKV = 17 * MiB;
constexpr size_t WS_WQ1 = 23 * MiB;
constexpr size_t WS_WO = 25 * MiB;
constexpr size_t WS_POOL = 29 * MiB;
constexpr size_t WS_XB = 32 * MiB;
constexpr size_t WS_K = 64 * MiB, WS_V = 96 * MiB;
constexpr size_t WS_A = 128 * MiB;
constexpr size_t WS_Q = 128 * MiB, WS_O = 132 * MiB, WS_MB = 192 * MiB;
constexpr size_t Q8_BGAP = 14 * MiB;
constexpr size_t QO_BGAP = 6 * MiB;
constexpr int CW_BAR = 4096;

__device__ __forceinline__ float row_rstd(const float* ssq, int row) { return rsqrtf((ssq[row] + ssq[M + row] + ssq[2 * M + row] + ssq[3 * M + row]) * (1.f / DM) + EPS); }
__device__ __forceinline__ float wave_max(float v) { for (int o = 1; o < 64; o <<= 1) v = fmaxf(v, __shfl_xor(v, o)); return v; }
__device__ __forceinline__ float wave_sum(float v) { for (int o = 1; o < 64; o <<= 1) v += __shfl_xor(v, o); return v; }
__device__ __forceinline__ int t5_bucket(int rel) {
    if (rel < 16) return rel;
    int l = 16 + (int)(logf((float)rel / 16.f) / logf(8.f) * 16.f);
    return l < 31 ? l : 31;
}
namespace pg8 {
#define PG8_LAS __attribute__((address_space(3)))
typedef unsigned short bf16_t;
typedef short bf16x8 __attribute__((ext_vector_type(8)));
typedef float f32x4 __attribute__((ext_vector_type(4)));
typedef unsigned u32x4 __attribute__((ext_vector_type(4)));
constexpr int BM = 256, BK = 64, HALF = 128, HTB = HALF * BK * 2  , STAGE_BYTES = 8 * HTB, NXCD = 8, WGM = 8;

__host__ __device__ __forceinline__ int lds_byte(int r, int c) { const int st = (r >> 4) * 2 + (c >> 5), rr = r & 15, cc = c & 31, ob = rr * 64 + cc * 2; return st * 1024 + (ob ^ (((ob >> 9) & 1) << 5)); }
__host__ __device__ __forceinline__ void stage_rc(int b, int& R, int& C) { const int st = b / 1024, sb = b % 1024, swz = sb ^ (((sb >> 9) & 1) << 5); R = (st >> 1) * 16 + swz / 64; C = (st & 1) * 32 + (swz % 64) / 2; }
__host__ __device__ __forceinline__ int perm32(int rho) { const int n = rho >> 4, i = rho & 15; return 8 * (i >> 2) + 4 * n + (i & 3); }

struct Unit { int pm, pn; };
struct Gemm { const bf16_t* A; const bf16_t* Bt; int M, N, K; size_t a_grp, a_bat; };

struct StaticOrder {
    int nM, nN, nwg, G, c;
    __host__ __device__ __forceinline__ void init(int M, int N, int G_, int c_) { nM = M / BM; nN = N / BM; nwg = nM * nN; G = G_; c = c_; }
    __host__ __device__ __forceinline__ bool next(int i, Unit& u) const {
        const long L = (long)i * G + c; if (L >= nwg) return false;
        int wgid = (int)L; { const int q = nwg / NXCD, r = nwg % NXCD, xcd = wgid % NXCD, off = wgid / NXCD; wgid = (xcd < r ? xcd * (q + 1) : r * (q + 1) + (xcd - r) * q) + off; }
        const int nig = WGM * nN, gid = wgid / nig, fm = gid * WGM, gsz = (nM - fm) < WGM ? (nM - fm) : WGM;
        u.pm = fm + ((wgid % nig) % gsz); u.pn = (wgid % nig) / gsz; return true;
    }
    __device__ __forceinline__ void a_ready(const Unit&) const {}
    __device__ __forceinline__ void done(const Unit&) const {}
};

__device__ __forceinline__ unsigned cvt_pk_bf16(float lo, float hi) { unsigned r; asm volatile("v_cvt_pk_bf16_f32 %0, %1, %2" : "=v"(r) : "v"(lo), "v"(hi)); return r; }
__device__ __forceinline__ float rstd_of(const float* ssq, int row) { return rsqrtf((ssq[row] + ssq[::M + row] + ssq[2 * ::M + row] + ssq[3 * ::M + row]) * (1.f / ::DM) + ::EPS); }

struct EpiMlpIn {
    static constexpr bool PERM = true, AFTER_DRAIN = false, HEADPERM = false;
    bf16_t* O;
    __device__ __forceinline__ void operator()(const f32x4 (&acc)[2][2][4][2], const Unit& u, int wr, int wc, int fr, int fq) const {
        const int row0 = u.pm * BM + wr * 64 + fr, col0 = u.pn * BM + wc * 32 + 8 * fq;
#pragma unroll
        for (int ai = 0; ai < 2; ++ai)
#pragma unroll
            for (int m = 0; m < 4; ++m) { const int row = row0 + ai * HALF + m * 16; bf16_t* rowp = O + (size_t)row * ::FF + col0;
#pragma unroll
                for (int bj = 0; bj < 2; ++bj) { f32x4 v0 = acc[ai][bj][m][0], v1 = acc[ai][bj][m][1];
#pragma unroll
                    for (int e = 0; e < 4; ++e) { v0[e] = fmaxf(v0[e] * __builtin_fabsf(v0[e]), 0.f); v1[e] = fmaxf(v1[e] * __builtin_fabsf(v1[e]), 0.f); }
                    u32x4 w; w.x = cvt_pk_bf16(v0[0], v0[1]); w.y = cvt_pk_bf16(v0[2], v0[3]); w.z = cvt_pk_bf16(v1[0], v1[1]); w.w = cvt_pk_bf16(v1[2], v1[3]);
                    *(u32x4*)(rowp + bj * HALF) = w; } }
    }
};

struct EpiQKV {
    static constexpr bool PERM = true, AFTER_DRAIN = false, HEADPERM = true;
    unsigned char* q; unsigned char* k; bf16_t* v; const float* ssq; const float* qn; const float* kn; int part0; const float* ssq_old; const float* colmax;
    __device__ __forceinline__ void operator()(const f32x4 (&acc)[2][2][4][2], const Unit& u, int wr, int wc, int fr, int fq) const {
        const int part = part0 + (u.pn >> 2), seg = (u.pn & 3) * 4 + wc;
        bf16_t* dst = v + seg * 64 + 8 * fq; unsigned char* dst8 = (part == 0 ? q + (size_t)(u.pm >> 3) * ::Q8_BGAP : k) + seg * 64 + 8 * fq;
        const float* gw = part == 0 ? qn : kn; const float gs = part == 0 ? ::LOG2E : 1.f;
        const int row0 = u.pm * BM + wr * 64 + fr;
        const float sc0 = colmax[u.pn * 8 + wc * 2] * (1.f / 127.f), sc1 = colmax[u.pn * 8 + wc * 2 + 1] * (1.f / 127.f);
        float rs[2][4];
#pragma unroll
        for (int ai = 0; ai < 2; ++ai)
#pragma unroll
            for (int m = 0; m < 4; ++m) rs[ai][m] = rstd_of(ssq, row0 + ai * HALF + m * 16) * (8.f / 127.f) / rstd_of(ssq_old, row0 + ai * HALF + m * 16);
#pragma unroll
        for (int ai = 0; ai < 2; ++ai)
#pragma unroll
            for (int m = 0; m < 4; ++m) { const int row = row0 + ai * HALF + m * 16; const float r = rs[ai][m];
                f32x4 x[2][2]; float s = 0.f;
#pragma unroll
                for (int bj = 0; bj < 2; ++bj)
#pragma unroll
                    for (int n = 0; n < 2; ++n) { typedef int v4i_ __attribute__((ext_vector_type(4))); const v4i_ ai_ = __builtin_bit_cast(v4i_, acc[ai][bj][m][n]);
                        x[bj][n] = (f32x4){(float)ai_[0], (float)ai_[1], (float)ai_[2], (float)ai_[3]} * (r * (bj ? sc1 : sc0)); const f32x4 t = x[bj][n] * x[bj][n]; s += (t[0] + t[1]) + (t[2] + t[3]); }
                s += __shfl_xor(s, 16); s += __shfl_xor(s, 32);
                const float hr = part < 2 ? rsqrtf(s * (1.f / 64.f) + ::EPS) : 1.f;
#pragma unroll
                for (int bj = 0; bj < 2; ++bj) { const f32x4 one_ = {1.f, 1.f, 1.f, 1.f};
                    const f32x4 w0 = part < 2 ? *(const f32x4*)(gw + 32 * bj + 8 * fq) * gs : one_, w1 = part < 2 ? *(const f32x4*)(gw + 32 * bj + 8 * fq + 4) * gs : one_;
                    const f32x4 y0 = x[bj][0] * hr * w0, y1 = x[bj][1] * hr * w1;
                    if (part < 2) { int lo = __builtin_amdgcn_cvt_pk_fp8_f32(y0[0], y0[1], 0, false); lo = __builtin_amdgcn_cvt_pk_fp8_f32(y0[2], y0[3], lo, true);
                        int hi = __builtin_amdgcn_cvt_pk_fp8_f32(y1[0], y1[1], 0, false); hi = __builtin_amdgcn_cvt_pk_fp8_f32(y1[2], y1[3], hi, true);
                        typedef int i32x2_ __attribute__((ext_vector_type(2))); *(i32x2_*)(dst8 + (size_t)row * 1024 + 32 * bj) = (i32x2_){lo, hi}; }
                    else { u32x4 o; o.x = cvt_pk_bf16(y0[0], y0[1]); o.y = cvt_pk_bf16(y0[2], y0[3]); o.z = cvt_pk_bf16(y1[0], y1[1]); o.w = cvt_pk_bf16(y1[2], y1[3]);
                        *(u32x4*)(dst + (size_t)row * ::DM + 32 * bj) = o; } } }
    }
};

struct EpiResid {
    static constexpr bool PERM = true, AFTER_DRAIN = true, HEADPERM = false;
    const float* xin_f32; float* xout_f32; bf16_t* xb; const float* scale; float* ssq; const float* rsq_in; unsigned char* xq = nullptr;
    __device__ __forceinline__ void fused(f32x4 (&acc)[2][2][4][2], const Unit& u, int wr, int wc, int fr, int fq, PG8_LAS unsigned char* lds, int wid, int lane) const {
        PG8_LAS float* P = (PG8_LAS float*)lds;
        const int col0 = u.pn * BM + wc * 32 + 8 * fq;
        if (rsq_in) {
#pragma unroll
            for (int ai = 0; ai < 2; ++ai)
#pragma unroll
                for (int m = 0; m < 4; ++m) { const float r = rstd_of(rsq_in, u.pm * BM + ai * HALF + wr * 64 + m * 16 + fr), r2 = r * r;
#pragma unroll
                    for (int bj = 0; bj < 2; ++bj)
#pragma unroll
                        for (int n = 0; n < 2; ++n) acc[ai][bj][m][n] *= r2; }
        }
        if (scale) {
#pragma unroll
            for (int bj = 0; bj < 2; ++bj)
#pragma unroll
                for (int n = 0; n < 2; ++n) { const f32x4 sv = *(const f32x4*)(scale + col0 + bj * HALF + n * 4);
#pragma unroll
                    for (int ai = 0; ai < 2; ++ai)
#pragma unroll
                        for (int m = 0; m < 4; ++m) acc[ai][bj][m][n] *= sv; }
        }
#pragma unroll
        for (int ai = 0; ai < 2; ++ai) {
            u32x4 xr[4][2]; f32x4 xf[4][2][2];
            if (xin_f32) {
#pragma unroll
                for (int m = 0; m < 4; ++m)
#pragma unroll
                    for (int bj = 0; bj < 2; ++bj) { const float* p = xin_f32 + (size_t)(u.pm * BM + ai * HALF + wr * 64 + m * 16 + fr) * ::DM + col0 + bj * HALF; xf[m][bj][0] = *(const f32x4*)p; xf[m][bj][1] = *(const f32x4*)(p + 4); }
            } else {
#pragma unroll
                for (int m = 0; m < 4; ++m)
#pragma unroll
                    for (int bj = 0; bj < 2; ++bj) xr[m][bj] = *(const u32x4*)(xb + (size_t)(u.pm * BM + ai * HALF + wr * 64 + m * 16 + fr) * ::DM + col0 + bj * HALF);
#pragma unroll
                for (int m = 0; m < 4; ++m)
#pragma unroll
                    for (int bj = 0; bj < 2; ++bj) { const u32x4 w = xr[m][bj];
                        xf[m][bj][0] = (f32x4){__uint_as_float(w.x << 16), __uint_as_float(w.x & 0xffff0000u), __uint_as_float(w.y << 16), __uint_as_float(w.y & 0xffff0000u)};
                        xf[m][bj][1] = (f32x4){__uint_as_float(w.z << 16), __uint_as_float(w.z & 0xffff0000u), __uint_as_float(w.w << 16), __uint_as_float(w.w & 0xffff0000u)}; }
            }
#pragma unroll
            for (int m = 0; m < 4; ++m) { const int r = ai * HALF + wr * 64 + m * 16 + fr; const size_t off = (size_t)(u.pm * BM + r) * ::DM + col0; float s = 0.f;
                const float qinv = xq ? (127.f / 8.f) * rstd_of(rsq_in, u.pm * BM + r) : 0.f;
#pragma unroll
                for (int bj = 0; bj < 2; ++bj) { const f32x4 y0 = xf[m][bj][0] + acc[ai][bj][m][0], y1 = xf[m][bj][1] + acc[ai][bj][m][1];
                    u32x4 w; w.x = cvt_pk_bf16(y0[0], y0[1]); w.y = cvt_pk_bf16(y0[2], y0[3]); w.z = cvt_pk_bf16(y1[0], y1[1]); w.w = cvt_pk_bf16(y1[2], y1[3]);
                    *(u32x4*)(xb + off + bj * HALF) = w;
                    if (xq) { unsigned t_[8];
#pragma unroll
                        for (int i = 0; i < 4; ++i) { t_[i] = __float_as_uint(__builtin_amdgcn_fmed3f(y0[i] * qinv, -127.f, 127.f) + 12582912.f); t_[4 + i] = __float_as_uint(__builtin_amdgcn_fmed3f(y1[i] * qinv, -127.f, 127.f) + 12582912.f); }
                        typedef unsigned u32x2_ __attribute__((ext_vector_type(2))); u32x2_ o8;
                        o8.x = __builtin_amdgcn_perm(t_[1], t_[0], 0x0c0c0400u) | __builtin_amdgcn_perm(t_[3], t_[2], 0x04000c0cu);
                        o8.y = __builtin_amdgcn_perm(t_[5], t_[4], 0x0c0c0400u) | __builtin_amdgcn_perm(t_[7], t_[6], 0x04000c0cu);
                        *(u32x2_*)(xq + off + bj * HALF) = o8; }
                    if (xout_f32) { *(f32x4*)(xout_f32 + off + bj * HALF) = y0; *(f32x4*)(xout_f32 + off + bj * HALF + 4) = y1; }
                    const f32x4 t0 = y0 * y0, t1 = y1 * y1; s += ((t0[0] + t0[1]) + (t0[2] + t0[3])) + ((t1[0] + t1[1]) + (t1[2] + t1[3])); }
                s += __shfl_xor(s, 16); s += __shfl_xor(s, 32);
                if (fq == 0) P[r * 4 + wc] = s; }
            asm volatile("" ::: "memory");
        }
        asm volatile("s_waitcnt lgkmcnt(0)" ::: "memory"); __builtin_amdgcn_s_barrier(); asm volatile("" ::: "memory");
        const int t = wid * 64 + lane;
        if (t < 256) ssq[(size_t)u.pn * ::M + u.pm * BM + t] = (P[t * 4 + 0] + P[t * 4 + 1]) + (P[t * 4 + 2] + P[t * 4 + 3]);
    }
};

template <class Epi, class Sched, bool ALIGN_EPI = false, bool SP2 = false, bool I8 = false>
__device__ __forceinline__ void gemm_phase(PG8_LAS unsigned char* lds, const Gemm g, const Sched& S, const Epi& E, const int tid) {
    const int wid = __builtin_amdgcn_readfirstlane(tid >> 6), lane = tid & 63, wr = wid >> 2, wc = wid & 3, fr = lane & 15, fq = lane >> 4;
    const int K = g.K, nt = K / BK;
    unsigned voffA[2], voffB[2];
#pragma unroll
    for (int i = 0; i < 2; ++i) { int R, C; stage_rc(tid * 16 + i * 8192, R, C); const int Rb = Epi::HEADPERM ? ((R >> 5) * 64 + perm32(R & 31)) : (Epi::PERM ? ((R & ~31) + perm32(R & 31)) : R);
        voffA[i] = (unsigned)(R * K + C) * 2u; voffB[i] = (unsigned)(Rb * K + C) * 2u; }
    const size_t kstep = (size_t)(BK * 2);
    const size_t hstep = (size_t)HALF * K * 2;
    const size_t tstep = 2 * hstep; const size_t hstepB = Epi::HEADPERM ? (size_t)32 * K * 2 : hstep;
    const unsigned ldsw = (unsigned)wid * 1024u;
    const int aoff = lds_byte(wr * 64 + fr, fq * 8), boff = lds_byte(wc * 32 + fr, fq * 8);
#define PG8_SA(b, h) (((b) * 2 + (h)) * HTB)
#define PG8_SB(b, h) ((4 + (b) * 2 + (h)) * HTB)
#define PG8_STAGE(bufoff, gbase, voff) do { _Pragma("unroll") for (int _i = 0; _i < 2; ++_i) \
        __builtin_amdgcn_global_load_lds((const unsigned*)((const char*)(gbase) + (voff)[_i]), (PG8_LAS unsigned*)(lds + (bufoff) + ldsw + _i * 8192), 16, 0, 0); } while (0)
#define PG8_LDA(dst, b, h) do { _Pragma("unroll") for (int m = 0; m < 4; ++m) _Pragma("unroll") for (int k = 0; k < 2; ++k) dst[m][k] = *(const PG8_LAS bf16x8*)(lds + PG8_SA(b, h) + aoff + m * 2048 + k * 1024); } while (0)
#define PG8_LDB(dst, b, h) do { _Pragma("unroll") for (int n = 0; n < 2; ++n) _Pragma("unroll") for (int k = 0; k < 2; ++k) dst[n][k] = *(const PG8_LAS bf16x8*)(lds + PG8_SB(b, h) + boff + n * 2048 + k * 1024); } while (0)
#define PG8_MMA(ai, bj, At, Bt) do { __builtin_amdgcn_s_setprio(1); _Pragma("unroll") for (int m = 0; m < 4; ++m) _Pragma("unroll") for (int n = 0; n < 2; ++n) _Pragma("unroll") for (int k = 0; k < 2; ++k) \
        { if constexpr (I8) { typedef int v4i_ __attribute__((ext_vector_type(4))); acc[ai][bj][m][n] = __builtin_bit_cast(f32x4, __builtin_amdgcn_mfma_i32_16x16x64_i8(__builtin_bit_cast(v4i_, Bt[n][k]), __builtin_bit_cast(v4i_, At[m][k]), __builtin_bit_cast(v4i_, acc[ai][bj][m][n]), 0, 0, 0)); } \
          else acc[ai][bj][m][n] = __builtin_amdgcn_mfma_f32_16x16x32_bf16(Bt[n][k], At[m][k], acc[ai][bj][m][n], 0, 0, 0); } __builtin_amdgcn_s_setprio(0); } while (0)
#define PG8_WAIT_V(n) asm volatile("s_waitcnt vmcnt(" #n ")" ::: "memory")
#define PG8_WAIT_L(n) asm volatile("s_waitcnt lgkmcnt(" #n ")" ::: "memory")
#define PG8_BAR __builtin_amdgcn_s_barrier()
#define PG8_SCHED __builtin_amdgcn_sched_barrier(0)
    Unit cur, nxt; int ui = 0;
    if (!S.next(0, cur)) return;
    f32x4 acc[2][2][4][2];
#pragma unroll
    for (int a = 0; a < 2; ++a)
#pragma unroll
        for (int b = 0; b < 2; ++b)
#pragma unroll
            for (int m = 0; m < 4; ++m)
#pragma unroll
                for (int n = 0; n < 2; ++n) acc[a][b][m][n] = (f32x4){0.f, 0.f, 0.f, 0.f};
    bf16x8 At[4][2], B0[2][2], B1[2][2];
    const char* cA = (const char*)g.A + (size_t)cur.pm * tstep + (size_t)cur.pn * g.a_grp + (size_t)(cur.pm >> 3) * g.a_bat; const char* cB = (const char*)g.Bt + (size_t)cur.pn * tstep;
    S.a_ready(cur);
    if constexpr (SP2) {
        PG8_STAGE(PG8_SB(0, 0), cB, voffB); PG8_STAGE(PG8_SB(0, 1), cB + hstepB, voffB); PG8_STAGE(PG8_SA(0, 0), cA, voffA); PG8_STAGE(PG8_SA(0, 1), cA + hstep, voffA);
        if (wr == 1) PG8_BAR;
        PG8_WAIT_V(2); PG8_BAR;
        PG8_STAGE(PG8_SB(1, 0), cB + kstep, voffB); PG8_STAGE(PG8_SA(1, 0), cA + kstep, voffA); PG8_STAGE(PG8_SB(1, 1), cB + hstepB + kstep, voffB);
        PG8_WAIT_V(6); PG8_BAR;
    } else {
        PG8_STAGE(PG8_SB(0, 0), cB, voffB); PG8_STAGE(PG8_SA(0, 0), cA, voffA); PG8_STAGE(PG8_SB(0, 1), cB + hstepB, voffB); PG8_STAGE(PG8_SA(0, 1), cA + hstep, voffA);
        if (wr == 1) PG8_BAR;
        PG8_WAIT_V(4); PG8_BAR;
        PG8_STAGE(PG8_SB(1, 0), cB + kstep, voffB); PG8_STAGE(PG8_SA(1, 0), cA + kstep, voffA); PG8_STAGE(PG8_SB(1, 1), cB + hstepB + kstep, voffB);
        PG8_WAIT_V(6); PG8_BAR;
    }
    for (;;) {
        const bool has_next = S.next(ui + 1, nxt);
        const char* nA = has_next ? (const char*)g.A + (size_t)nxt.pm * tstep + (size_t)nxt.pn * g.a_grp + (size_t)(nxt.pm >> 3) * g.a_bat : cA; const char* nB = has_next ? (const char*)g.Bt + (size_t)nxt.pn * tstep : cB;
        for (int t = 0; t < nt; t += 2) {
            const bool last = (t == nt - 2);
            const char* a1 = cA + (size_t)(t + 1) * kstep;
            const char* a2 = last ? nA : cA + (size_t)(t + 2) * kstep; const char* b2 = last ? nB : cB + (size_t)(t + 2) * kstep;
            const char* a3 = a2 + kstep; const char* b3 = b2 + kstep;
            if (last && has_next) S.a_ready(nxt);
            if constexpr (SP2) {
            PG8_LDB(B0, 0, 0); PG8_LDB(B1, 0, 1); PG8_SCHED; PG8_LDA(At, 0, 0); PG8_STAGE(PG8_SA(1, 1), a1 + hstep, voffA);
            PG8_WAIT_V(8); PG8_WAIT_L(0); PG8_BAR; PG8_MMA(0, 0, At, B0); PG8_MMA(0, 1, At, B1); PG8_BAR; PG8_SCHED;
            PG8_LDA(At, 0, 1); PG8_STAGE(PG8_SB(0, 0), b2, voffB); PG8_STAGE(PG8_SB(0, 1), b2 + hstepB, voffB); PG8_STAGE(PG8_SA(0, 0), a2, voffA);
            PG8_WAIT_V(8); PG8_WAIT_L(0); PG8_BAR; PG8_MMA(1, 0, At, B0); PG8_MMA(1, 1, At, B1); PG8_BAR; PG8_SCHED;
            PG8_LDB(B0, 1, 0); PG8_LDB(B1, 1, 1); PG8_SCHED; PG8_LDA(At, 1, 0); PG8_STAGE(PG8_SA(0, 1), a2 + hstep, voffA);
            PG8_WAIT_V(8); PG8_WAIT_L(0); PG8_BAR; PG8_MMA(0, 0, At, B0); PG8_MMA(0, 1, At, B1); PG8_BAR; PG8_SCHED;
            PG8_LDA(At, 1, 1); PG8_STAGE(PG8_SB(1, 0), b3, voffB); PG8_STAGE(PG8_SB(1, 1), b3 + hstepB, voffB); PG8_STAGE(PG8_SA(1, 0), a3, voffA);
            PG8_WAIT_V(8); PG8_WAIT_L(0); PG8_BAR; PG8_MMA(1, 0, At, B0); PG8_MMA(1, 1, At, B1); PG8_BAR; PG8_SCHED;
            } else {
            PG8_LDB(B0, 0, 0); PG8_SCHED; PG8_LDA(At, 0, 0); PG8_STAGE(PG8_SA(1, 1), a1 + hstep, voffA);
            PG8_WAIT_L(8); PG8_BAR; PG8_WAIT_L(0); PG8_MMA(0, 0, At, B0); PG8_BAR; PG8_SCHED;
            PG8_LDB(B1, 0, 1); PG8_STAGE(PG8_SB(0, 0), b2, voffB);
            PG8_BAR; PG8_WAIT_L(0); PG8_MMA(0, 1, At, B1); PG8_BAR;
            PG8_LDA(At, 0, 1); PG8_STAGE(PG8_SA(0, 0), a2, voffA);
            PG8_BAR; PG8_WAIT_L(0); PG8_MMA(1, 0, At, B0); PG8_BAR; PG8_SCHED;
            PG8_STAGE(PG8_SB(0, 1), b2 + hstepB, voffB);
            PG8_WAIT_V(6); PG8_BAR; PG8_MMA(1, 1, At, B1); PG8_BAR;
            PG8_LDB(B0, 1, 0); PG8_SCHED; PG8_LDA(At, 1, 0); PG8_STAGE(PG8_SA(0, 1), a2 + hstep, voffA);
            PG8_WAIT_L(8); PG8_BAR; PG8_WAIT_L(0); PG8_MMA(0, 0, At, B0); PG8_BAR; PG8_SCHED;
            PG8_LDB(B1, 1, 1); PG8_STAGE(PG8_SB(1, 0), b3, voffB);
            PG8_BAR; PG8_WAIT_L(0); PG8_MMA(0, 1, At, B1); PG8_BAR;
            PG8_LDA(At, 1, 1); PG8_STAGE(PG8_SA(1, 0), a3, voffA);
            PG8_BAR; PG8_WAIT_L(0); PG8_MMA(1, 0, At, B0); PG8_BAR; PG8_SCHED;
            PG8_STAGE(PG8_SB(1, 1), b3 + hstepB, voffB);
            PG8_WAIT_V(6); PG8_BAR; PG8_MMA(1, 1, At, B1); PG8_BAR;
            }
        }
        if constexpr (ALIGN_EPI) { if (wr == 0) PG8_BAR; }
        if constexpr (!Epi::AFTER_DRAIN) { E(acc, cur, wr, wc, fr, fq); S.done(cur); }
        if (!has_next) break;
#pragma unroll
        for (int a = 0; a < 2; ++a)
#pragma unroll
            for (int b = 0; b < 2; ++b)
#pragma unroll
                for (int m = 0; m < 4; ++m)
#pragma unroll
                    for (int n = 0; n < 2; ++n) acc[a][b][m][n] = (f32x4){0.f, 0.f, 0.f, 0.f};
        cur = nxt; cA = nA; cB = nB; ++ui;
        if constexpr (ALIGN_EPI) { if (wr == 1) PG8_BAR; }
    }
    PG8_WAIT_V(0);
    if constexpr (!ALIGN_EPI) { if (wr == 0) PG8_BAR; }
    PG8_BAR;
    if constexpr (Epi::AFTER_DRAIN) { E.fused(acc, cur, wr, wc, fr, fq, lds, wid, lane); S.done(cur); }
#undef PG8_SA
#undef PG8_SB
#undef PG8_STAGE
#undef PG8_LDA
#undef PG8_LDB
#undef PG8_MMA
#undef PG8_WAIT_V
#undef PG8_WAIT_L
#undef PG8_BAR
#undef PG8_SCHED
}
}
#define GAS __attribute__((address_space(1)))
#define LAS __attribute__((address_space(3)))
typedef unsigned v4u __attribute__((ext_vector_type(4)));
typedef unsigned v2u __attribute__((ext_vector_type(2)));
typedef float f32x4 __attribute__((ext_vector_type(4)));
typedef GAS unsigned gu32;
#define LDS_WAIT() asm volatile("s_waitcnt lgkmcnt(0)" ::: "memory")
#define VM_WAIT() asm volatile("s_waitcnt vmcnt(0)" ::: "memory")
constexpr int NWAVES = 8;
constexpr int RING_BYTES = 131072, LDSCTL_OFF = RING_BYTES, MISC_OFF = LDSCTL_OFF + 320, LDS_BYTES = 147456;

#define XB_LGRP(j)  (16 + (j))
#define XB_TMO      128
#define XB_XCNT(j)  (256  + 64 * (j))
#define XB_XSUB(j)  (1280 + 64 * (j))
#define XB_XGEN(j)  (2304 + 64 * (j))
#define XB_TOP      3328
#define XB_TOPGEN   3392
#define XCD_BAR_WORDS 3456
#define XB_SPIN_CAP (1u << 18)

__device__ __forceinline__ unsigned xb_ld(unsigned* p)              { return __hip_atomic_load(p, __ATOMIC_RELAXED, __HIP_MEMORY_SCOPE_AGENT); }
__device__ __forceinline__ unsigned xb_add(unsigned* p, unsigned v) { return __hip_atomic_fetch_add(p, v, __ATOMIC_RELAXED, __HIP_MEMORY_SCOPE_AGENT); }
__device__ __forceinline__ unsigned xb_xcc_id() { return (unsigned)__builtin_amdgcn_s_getreg((3 << 11) | 20) & 0xFu; }
#define XB_SPIN(cond, bar) do { unsigned _sp = 0; while (cond) { __builtin_amdgcn_s_sleep(1); \
    if ((++_sp & 255u) == 0u) { if (xb_ld(&(bar)[XB_TMO])) break; if (_sp > XB_SPIN_CAP) { atomicAdd(&(bar)[XB_TMO], 1u); break; } } } } while (0)

struct XcdBarrier {
    unsigned* bar; unsigned x;
    volatile LAS unsigned* st;
};

__device__ __forceinline__ XcdBarrier xcd_barrier_post(unsigned* bar, volatile LAS unsigned* st, unsigned lgroup) {
    XcdBarrier b; b.bar = bar; b.x = xb_xcc_id(); b.st = st;
    if (threadIdx.x == 0) { (void)xb_add(&bar[XB_XCNT(b.x)], 1u); (void)__hip_atomic_fetch_or(&bar[XB_LGRP(lgroup & 15u)], 1u << b.x, __ATOMIC_RELAXED, __HIP_MEMORY_SCOPE_AGENT); }
    return b;
}
__device__ __forceinline__ void xcd_barrier_check_regular(const XcdBarrier& b, unsigned ngroups, unsigned per_group) {
    if (threadIdx.x == 0) {
        unsigned all = 0u, ok = (b.st[0] == per_group && b.st[1] == ngroups) ? 1u : 0u;
        for (unsigned j = 0; j < ngroups; ++j) { const unsigned w = xb_ld(&b.bar[XB_LGRP(j)]); ok &= (w != 0u && (w & (w - 1u)) == 0u && (all & w) == 0u) ? 1u : 0u; all |= w; }
        b.st[5] = ok;
    }
    __syncthreads();
}
__device__ __forceinline__ void xcd_barrier_complete(unsigned* bar, unsigned x, unsigned& nloc, unsigned& nx) {
    const unsigned G = gridDim.x * gridDim.y * gridDim.z;
    unsigned sum, cnt, mine, sp = 0u;
    for (;;) {
        sum = 0u; cnt = 0u; mine = 0u;
#pragma unroll
        for (unsigned j = 0; j < 16; ++j) { const unsigned c = xb_ld(&bar[XB_XCNT(j)]); sum += c; cnt += (c > 0u) ? 1u : 0u; mine = (j == x) ? c : mine; }
        if (sum == G) break;
        __builtin_amdgcn_s_sleep(1);
        if ((++sp & 255u) == 0u) { if (xb_ld(&bar[XB_TMO])) break; if (sp > XB_SPIN_CAP) { atomicAdd(&bar[XB_TMO], 1u); break; } }
    }
    nloc = mine > 0u ? mine : 1u; nx = cnt > 0u ? cnt : 1u;
}

__device__ __forceinline__ void xcd_barrier_arrive(const XcdBarrier& b, bool local = false) {
    asm volatile("s_waitcnt vmcnt(0)" ::: "memory");
    __syncthreads();
    if (threadIdx.x == 0) {
        unsigned* bar = b.bar;
        __builtin_amdgcn_s_waitcnt(0);
        unsigned nloc = b.st[0], nx = b.st[1];
        if (nloc == 0u) { xcd_barrier_complete(bar, b.x, nloc, nx); b.st[0] = nloc; b.st[1] = nx; }
        const unsigned old = xb_add(&bar[XB_XSUB(b.x)], 1u);
        const unsigned gen = old / nloc;
        unsigned role = 0u, tg = 0u;
        if (old + 1u == (gen + 1u) * nloc && local) role = 2u;
        else if (old + 1u == (gen + 1u) * nloc) {
            __builtin_amdgcn_fence(__ATOMIC_RELEASE, "agent");
            asm volatile("s_waitcnt vmcnt(0)" ::: "memory");
            const unsigned og = xb_add(&bar[XB_TOP], 1u);
            tg = og / nx;
            if (og + 1u == (tg + 1u) * nx) { xb_add(&bar[XB_TOPGEN], 1u); role = 2u; }
            else role = 1u;
        }
        b.st[2] = role; b.st[3] = gen; b.st[4] = tg;
    }
}
__device__ __forceinline__ void xcd_barrier_wait(const XcdBarrier& b) {
    if (threadIdx.x == 0) {
        unsigned* bar = b.bar;
        const unsigned role = b.st[2], gen = b.st[3], tg = b.st[4];
        if (role != 0u) {
            if (role == 1u) XB_SPIN(xb_ld(&bar[XB_TOPGEN]) == tg, bar);
            __builtin_amdgcn_fence(__ATOMIC_ACQUIRE, "agent");
            xb_add(&bar[XB_XGEN(b.x)], 1u);
            asm volatile("s_waitcnt vmcnt(0)" ::: "memory");
        } else {
            XB_SPIN(xb_ld(&bar[XB_XGEN(b.x)]) == gen, bar);
            __builtin_amdgcn_fence(__ATOMIC_ACQUIRE, "agent");
            asm volatile("s_waitcnt vmcnt(0)" ::: "memory");
        }
    }
    __syncthreads();
}

namespace attn {
using bf16x8 = __attribute__((ext_vector_type(8))) short;
using s16x4 = __attribute__((ext_vector_type(4))) short;
using f32x16 = __attribute__((ext_vector_type(16))) float;
using u32x4 = __attribute__((ext_vector_type(4))) unsigned;
typedef float f32x2_t __attribute__((ext_vector_type(2))); typedef __bf16 bf16x2_t __attribute__((ext_vector_type(2)));
typedef short v4i16_t __attribute__((ext_vector_type(4)));
typedef __attribute__((address_space(3))) const char* lds_cptr;
constexpr int SLOTB = 32768, NSLOT = 4, LDS_WS = NSLOT * SLOTB + 1024, LDS_TB = LDS_WS + 2048, STG_PITCH = 132, TB_N = 384, TB_OFF = 127;
constexpr float THR = 8.f;
__device__ __forceinline__ int crow(int r, int hi) { return (r & 3) + 8 * (r >> 2) + 4 * hi; }
__device__ __forceinline__ void glds16(const void* gsrc, unsigned lds_dst) { unsigned keep;
    asm volatile("s_mov_b32 %0, m0\n\ts_mov_b32 m0, %2\n\ts_nop 0\n\tglobal_load_lds_dwordx4 %1, off\n\ts_mov_b32 m0, %0" : "=&s"(keep) : "v"(gsrc), "s"(lds_dst) : "memory"); }
__device__ __forceinline__ unsigned cvtpk_s(float lo, float hi) { f32x2_t v = {lo, hi}; bf16x2_t b = __builtin_convertvector(v, bf16x2_t); return __builtin_bit_cast(unsigned, b); }
__device__ __forceinline__ s16x4 vtr(lds_cptr p) { return __builtin_bit_cast(s16x4, __builtin_amdgcn_ds_read_tr16_b64_v4i16((__attribute__((address_space(3))) v4i16_t*)p)); }
__device__ __forceinline__ float swap_other(float v) { auto rr = __builtin_amdgcn_permlane32_swap(__float_as_uint(v), __float_as_uint(v), false, false); return (threadIdx.x & 32) ? __uint_as_float(rr[0]) : __uint_as_float(rr[1]); }
__device__ __forceinline__ float max3f(float x, float y, float z) { float r; asm("v_max3_f32 %0, %1, %2, %3" : "=v"(r) : "v"(x), "v"(y), "v"(z)); return r; }
__device__ __forceinline__ float max2f(float x, float y) { float r; asm("v_max_f32_e32 %0, %1, %2" : "=v"(r) : "v"(x), "v"(y)); return r; }
#define SBAR() __builtin_amdgcn_sched_barrier(0)
#define ATT_WAIT_BAR(N) asm volatile("s_waitcnt vmcnt(" #N ") lgkmcnt(0)\n\ts_barrier" ::: "memory")

struct Params { const unsigned char* Q; const unsigned char* K; const bf16* V;     bf16* O; const float* rel_bias; const float* lq1; const float* lk1; const float* lq2; const float* lk2; const float* subln; float lambda_init; };

__device__ __forceinline__ void attn_unit(const Params& P, int b, int h, int qb, float lam, LAS unsigned char* lds, int tid) {
    const int lane = tid & 63, r32 = lane & 31, hi = lane >> 5, wid = __builtin_amdgcn_readfirstlane(tid >> 6), c = wid >> 2, rblk = wid & 3;
    const size_t rowbase = (size_t)b * SEQ; const int q0 = qb * 128, qw0 = q0 + 32 * rblk;
    const unsigned char* Kh = P.K + rowbase * 1024 + h * 128; const bf16* Vh = P.V + rowbase * DM + h * 128;
    const unsigned lds0 = (unsigned)(uintptr_t)lds;
    LAS float* wsf = (LAS float*)(lds + LDS_WS) + wid * 64; const LAS float* Tb = (const LAS float*)(lds + LDS_TB) + h * TB_N;
    const int NT = 2 * (qb + 1);
    const unsigned char* ksrc0 = Kh + (size_t)lane * 1024 + wid * 16;
    const bf16* vsrc0 = Vh + (size_t)(16 * (wid & 3) + (lane >> 2)) * DM + (wid >> 2) * 32 + (lane & 3) * 8; const bf16* vsrc1 = vsrc0 + 64;
#define ATT_DMA(t, slot) do { const size_t o_ = (size_t)(t) * 64 * DM; const unsigned d_ = lds0 + (slot) * SLOTB + wid * 1024; \
        glds16(ksrc0 + (size_t)(t) * 64 * 1024, (unsigned)__builtin_amdgcn_readfirstlane(d_)); \
        glds16(vsrc0 + o_, (unsigned)__builtin_amdgcn_readfirstlane(d_ + 16384)); glds16(vsrc1 + o_, (unsigned)__builtin_amdgcn_readfirstlane(d_ + 16384 + 8192)); } while (0)
    ATT_DMA(0, 0); if (NT > 1) ATT_DMA(1, 1);
    typedef int v8i_t __attribute__((ext_vector_type(8))); typedef int v4i_t __attribute__((ext_vector_type(4)));
    v8i_t qf;
    { const unsigned char* Qw = P.Q + (size_t)b * Q8_BGAP + (rowbase + qw0 + r32) * 1024 + h * 128 + c * 64 + hi * 32;
      const v4i_t q0_ = *(const v4i_t*)Qw, q1_ = *(const v4i_t*)(Qw + 16); qf = (v8i_t){q0_[0], q0_[1], q0_[2], q0_[3], q1_[0], q1_[1], q1_[2], q1_[3]}; }
    asm volatile("" : "+v"(qf));
    float l_run = 0.f; f32x16 o[4];
#pragma unroll
    for (int d = 0; d < 4; ++d) o[d] = f32x16{};
    const lds_cptr L3 = (lds_cptr)lds;
#define ATT_VRD(i, n) do { vlo[i] = vtr(vp + ((n) & 3) * 4096 + ((n) >> 2) * 1024); vhh[i] = vtr(vp + ((n) & 3) * 4096 + ((n) >> 2) * 1024 + 512); } while (0)
#define ATT_VBASE(sl) (L3 + (sl) * SLOTB + 16384 + ((lane >> 4) & 1) * 32 + (lane & 3) * 8 + (4 * hi + ((lane & 15) >> 2)) * 64)
#define ATT_PE(g, e) ((g) < 2 ? p0[8 * (g) + (e)] : p1[8 * ((g) - 2) + (e)])
#define ATT_EXPPAIR(g, d) do { const float x0_ = ATT_PE(g, 2 * (d)), x1_ = ATT_PE(g, 2 * (d) + 1); sacc += x0_ + x1_; pw[g][d] = cvtpk_s(x0_, x1_); } while (0)
    u32x4 pw[4]; int slot = 0;
    for (int t = 0; t < NT; ++t) {
        if (t + 1 < NT) ATT_WAIT_BAR(3); else ATT_WAIT_BAR(0);
        if (t + 2 < NT) ATT_DMA(t + 2, (slot + 2) & 3);
        const int kt0 = 64 * t;
        if (kt0 <= qw0 + 31) {
            const lds_cptr kp = L3 + slot * SLOTB + (4 * c + 2 * hi) * 1024 + r32 * 16;
            unsigned va_ = (unsigned)(uintptr_t)ATT_VBASE(slot); asm volatile("" : "+v"(va_));
            const lds_cptr vp = (lds_cptr)va_;
            v8i_t kf[2];
#pragma unroll
            for (int kb = 0; kb < 2; ++kb) { const v4i_t a_ = *(const __attribute__((address_space(3))) v4i_t*)(kp + kb * 512), b_ = *(const __attribute__((address_space(3))) v4i_t*)(kp + kb * 512 + 1024);
                kf[kb] = (v8i_t){a_[0], a_[1], a_[2], a_[3], b_[0], b_[1], b_[2], b_[3]}; }
            SBAR();
            f32x16 p0 = __builtin_amdgcn_mfma_scale_f32_32x32x64_f8f6f4(kf[0], qf, f32x16{}, 0, 0, 0, 0x7f7f7f7f, 0, 0x7c7c7c7c);
            f32x16 p1 = __builtin_amdgcn_mfma_scale_f32_32x32x64_f8f6f4(kf[1], qf, f32x16{}, 0, 0, 0, 0x7f7f7f7f, 0, 0x7c7c7c7c);
            SBAR();
            asm volatile("s_nop 15\n\ts_nop 7" : "+v"(p0), "+v"(p1));
            SBAR();
            s16x4 vlo[8], vhh[8];
#pragma unroll
            for (int n = 0; n < 8; ++n) ATT_VRD(n, n);
            SBAR();
            if ((qw0 - (kt0 + 63)) < 113) {
                const LAS float* tb = Tb + ((qw0 + r32) - (kt0 + 4 * hi) + TB_OFF - 59);
#pragma unroll
                for (int r = 0; r < 16; ++r) { const int ko = (r & 3) + 8 * (r >> 2); p0[r] += tb[59 - ko]; p1[r] += tb[27 - ko]; }
            }
            float sacc = 0.f;
#pragma unroll
            for (int r = 0; r < 16; ++r) { p0[r] = __builtin_amdgcn_exp2f(p0[r]); p1[r] = __builtin_amdgcn_exp2f(p1[r]); }
#pragma unroll
            for (int d = 0; d < 4; ++d) ATT_EXPPAIR(0, d);
            SBAR();
#pragma unroll
            for (int n = 0; n < 16; ++n) { const int i = n & 7; const bf16x8 vf = {vlo[i][0], vlo[i][1], vlo[i][2], vlo[i][3], vhh[i][0], vhh[i][1], vhh[i][2], vhh[i][3]};
                o[n & 3] = __builtin_amdgcn_mfma_f32_32x32x16_bf16(__builtin_bit_cast(bf16x8, pw[n >> 2]), vf, o[n & 3], 0, 0, 0);
                if (n < 8) ATT_VRD(i, n + 8);
                if (n < 12) { ATT_EXPPAIR((n >> 2) + 1, n & 3); asm volatile("" : "+v"(sacc), "+v"(pw[(n >> 2) + 1])); }
                SBAR(); }
            asm volatile("" :: "v"(va_));
            l_run += sacc;
        }
        slot = (slot + 1) & 3;
    }
#undef ATT_VRD
#undef ATT_VBASE
#undef ATT_PE
#undef ATT_EXPPAIR
    ATT_WAIT_BAR(0);
    { const float lt = l_run + swap_other(l_run); if (hi == 0) wsf[32 + r32] = (c == 1 ? lam : 1.f) / lt; }
    asm volatile("s_waitcnt lgkmcnt(0)" ::: "memory");
    float rl[16];
#pragma unroll
    for (int r = 0; r < 16; ++r) rl[r] = wsf[32 + crow(r, hi)];
    LAS float* stg = (LAS float*)lds + (size_t)(rblk * 32) * STG_PITCH;
    if (c == 1) {
#pragma unroll
        for (int r = 0; r < 16; ++r)
#pragma unroll
            for (int d = 0; d < 4; ++d) stg[crow(r, hi) * STG_PITCH + d * 32 + r32] = o[d][r] * rl[r];
    }
    ATT_WAIT_BAR(0);
    if (c == 0) {
#pragma unroll
        for (int r = 0; r < 16; ++r)
#pragma unroll
            for (int d = 0; d < 4; ++d) { LAS float* e = stg + crow(r, hi) * STG_PITCH + d * 32 + r32; *e = o[d][r] * rl[r] - *e; }
        asm volatile("s_waitcnt lgkmcnt(0)" ::: "memory");
        const int row = lane >> 1, half = lane & 1; const LAS f32x4* src = (const LAS f32x4*)(stg + row * STG_PITCH + half * 64);
        f32x4 v[16]; float ss = 0.f;
#pragma unroll
        for (int i = 0; i < 16; ++i) { v[i] = src[i]; const f32x4 t2 = v[i] * v[i]; ss += (t2[0] + t2[1]) + (t2[2] + t2[3]); }
        ss += __shfl_xor(ss, 1);
        const float rr = rsqrtf(ss * (1.f / 128.f) + EPS) * (1.f - P.lambda_init);
        bf16* orow = P.O + (size_t)b * QO_BGAP + (rowbase + qw0 + row) * DM + h * 128 + half * 64; const f32x4* sw = (const f32x4*)(P.subln + half * 64);
#pragma unroll
        for (int i = 0; i < 8; ++i) { const f32x4 a = v[2 * i] * rr * sw[2 * i], bq = v[2 * i + 1] * rr * sw[2 * i + 1];
            u32x4 w; w.x = cvtpk_s(a[0], a[1]); w.y = cvtpk_s(a[2], a[3]); w.z = cvtpk_s(bq[0], bq[1]); w.w = cvtpk_s(bq[2], bq[3]); *(u32x4*)(orow + 8 * i) = w; }
    }
    ATT_WAIT_BAR(0);
#undef ATT_DMA
}

__device__ __forceinline__ void attn_phase(const Params& P, LAS unsigned char* lds, int tid, int vcu) {
    const int lane = tid & 63, x = vcu >> 5, j2 = vcu & 31, j = j2 & 15;
    LAS float* Tb = (LAS float*)(lds + LDS_TB);
    for (int i = tid; i < NH * TB_N; i += 512) { const int h = i / TB_N, d = i % TB_N - TB_OFF;
        Tb[i] = d < 0 ? -INFINITY : (P.rel_bias[t5_bucket(d) * NH + h] - P.rel_bias[31 * NH + h]) * LOG2E; }
    const float lam = expf(wave_sum(P.lq1[lane] * P.lk1[lane])) - expf(wave_sum(P.lq2[lane] * P.lk2[lane])) + P.lambda_init;
    asm volatile("s_waitcnt lgkmcnt(0)" ::: "memory"); __syncthreads();
    for (int k = 0; k < 4; ++k) { const int bh = 8 * x + 2 * k + (j2 >> 4), qb = (k & 1) ? 15 - j : j; attn_unit(P, bh >> 3, bh & 7, qb, lam, lds, tid); }
}
#undef ATT_WAIT_BAR
#undef SBAR
}

struct Frame { LAS unsigned char* lds; int tid, lane, wave, vcu, G; };
__device__ __forceinline__ void conv_loads(const float* W, int N, int item, int lane, float (&v)[32]) {
    const int nblk = N / 32, kb = item / nblk, nb = item % nblk; const float* src = W + (size_t)(64 * kb + (lane >> 5)) * N + 32 * nb + (lane & 31);
#pragma unroll
    for (int i = 0; i < 32; ++i) v[i] = src[(size_t)(2 * i) * N];
}
__device__ __forceinline__ void conv_finish(int K, int N, const float* gain, bf16* WT, LAS float* scr, int item, int lane, const float (&v)[32]) {
    const int nblk = N / 32, kb = item / nblk, nb = item % nblk, k0 = 64 * kb, n0 = 32 * nb, c = lane & 7;
    float gv[8];
#pragma unroll
    for (int i = 0; i < 8; ++i) gv[i] = gain ? gain[k0 + 8 * c + i] : 1.f;
#pragma unroll
    for (int i = 0; i < 32; ++i) scr[(2 * i + (lane >> 5)) * 33 + (lane & 31)] = v[i];
    LDS_WAIT(); asm volatile("" ::: "memory");
#pragma unroll
    for (int j = 0; j < 4; ++j) { const int n = (lane >> 3) + 8 * j; const LAS float* s = scr + (8 * c) * 33 + n;
        v4u o; o.x = pk2(s[0 * 33] * gv[0], s[1 * 33] * gv[1]); o.y = pk2(s[2 * 33] * gv[2], s[3 * 33] * gv[3]); o.z = pk2(s[4 * 33] * gv[4], s[5 * 33] * gv[5]); o.w = pk2(s[6 * 33] * gv[6], s[7 * 33] * gv[7]);
        *(GAS v4u*)(WT + (size_t)(n0 + n) * K + k0 + 8 * c) = o; }
    LDS_WAIT(); asm volatile("" ::: "memory");
}
__device__ __forceinline__ void conv_mat(const Frame& F, const float* W, int K, int N, const float* gain, bf16* WT, int rot) {
    LAS float* scr = (LAS float*)(F.lds + F.wave * 16384);
    const int NGW = F.G * NWAVES, gw = (F.vcu * NWAVES + F.wave + rot) % NGW, nit = (K / 64) * (N / 32);
    for (int it = 2 * gw; it < nit; it += 2 * NGW) { float va[32], vb[32];
        conv_loads(W, N, it, F.lane, va); if (it + 1 < nit) conv_loads(W, N, it + 1, F.lane, vb);
        conv_finish(K, N, gain, WT, scr, it, F.lane, va); if (it + 1 < nit) conv_finish(K, N, gain, WT, scr, it + 1, F.lane, vb); }
}
__device__ __forceinline__ void conv_colmax(const Frame& F, const float* W, int K, int N, const float* gain, float* colmax, int rot) {
    const int NGW = F.G * NWAVES, gw = (F.vcu * NWAVES + F.wave + rot) % NGW, nit = (K / 64) * (N / 32), nblk = N / 32;
    for (int it = gw; it < nit; it += NGW) { float v[32]; conv_loads(W, N, it, F.lane, v);
        const int kb = it / nblk, nb = it % nblk; float m = 0.f;
#pragma unroll
        for (int i = 0; i < 32; ++i) m = fmaxf(m, fabsf(v[i] * (gain ? gain[64 * kb + 2 * i + (F.lane >> 5)] : 1.f)));
#pragma unroll
        for (int o = 1; o < 64; o <<= 1) m = fmaxf(m, __builtin_bit_cast(float, __builtin_amdgcn_ds_bpermute((F.lane ^ o) << 2, __builtin_bit_cast(int, m))));
        if (F.lane == 0) atomicMax((unsigned*)colmax + nb, __float_as_uint(m)); }
}
__device__ __forceinline__ void conv_finish_i8(int K, int N, const float* gain, const float* colmax, unsigned char* WT, LAS float* scr, int item, int lane, const float (&v)[32]) {
    const int nblk = N / 32, kb = item / nblk, nb = item % nblk, k0 = 64 * kb, n0 = 32 * nb, c = lane & 7;
    float gv[8];
#pragma unroll
    for (int i = 0; i < 8; ++i) gv[i] = gain ? gain[k0 + 8 * c + i] : 1.f;
#pragma unroll
    for (int i = 0; i < 32; ++i) scr[(2 * i + (lane >> 5)) * 33 + (lane & 31)] = v[i];
    LDS_WAIT(); asm volatile("" ::: "memory");
#pragma unroll
    for (int j = 0; j < 4; ++j) { const int n = (lane >> 3) + 8 * j; const LAS float* s = scr + (8 * c) * 33 + n;
        const float cm = colmax[nb], inv = cm > 0.f ? 127.f / cm : 0.f; unsigned t[8];
#pragma unroll
        for (int i = 0; i < 8; ++i) t[i] = __float_as_uint(__builtin_amdgcn_fmed3f(s[i * 33] * gv[i] * inv, -127.f, 127.f) + 12582912.f);
        v2u o; o.x = __builtin_amdgcn_perm(t[1], t[0], 0x0c0c0400u) | __builtin_amdgcn_perm(t[3], t[2], 0x04000c0cu); o.y = __builtin_amdgcn_perm(t[5], t[4], 0x0c0c0400u) | __builtin_amdgcn_perm(t[7], t[6], 0x04000c0cu);
        *(GAS v2u*)(WT + (size_t)(n0 + n) * K + k0 + 8 * c) = o; }
    LDS_WAIT(); asm volatile("" ::: "memory");
}
__device__ __forceinline__ void conv_mat_i8(const Frame& F, const float* W, int K, int N, const float* gain, const float* colmax, unsigned char* WT, int rot) {
    LAS float* scr = (LAS float*)(F.lds + F.wave * 16384);
    const int NGW = F.G * NWAVES, gw = (F.vcu * NWAVES + F.wave + rot) % NGW, nit = (K / 64) * (N / 32);
    for (int it = 2 * gw; it < nit; it += 2 * NGW) { float va[32], vb[32];
        conv_loads(W, N, it, F.lane, va); if (it + 1 < nit) conv_loads(W, N, it + 1, F.lane, vb);
        conv_finish_i8(K, N, gain, colmax, WT, scr, it, F.lane, va); if (it + 1 < nit) conv_finish_i8(K, N, gain, colmax, WT, scr, it + 1, F.lane, vb); }
}
__device__ __forceinline__ f32x4 ld_row4(const float* x, const bf16* xb, size_t idx) {
    if (x) return *(const GAS f32x4*)(x + idx);
    const v2u w = *(const GAS v2u*)(xb + idx); return (f32x4){__uint_as_float(w.x << 16), __uint_as_float(w.x & 0xffff0000u), __uint_as_float(w.y << 16), __uint_as_float(w.y & 0xffff0000u)};
}
template <int WIN> __device__ __forceinline__ void pool_walk(const float* x, const bf16* xb, const LAS float* rs, size_t rowb, int t0, int ts, int g, int lane, const f32x4 gv, bf16* MB) {
    const int ch = g * 256 + lane * 4;
    f32x4 prv[16], cur[16];
#pragma unroll
    for (int i = 0; i < 16; ++i) { const int t = ts - 16 + i; prv[i] = (f32x4){0.f, 0.f, 0.f, 0.f}; if (t >= 0) prv[i] = ld_row4(x, xb, (rowb + t) * DM + ch) * rs[t - t0 + 16]; }
    f32x4 s = {0.f, 0.f, 0.f, 0.f};
#pragma unroll
    for (int j = 1; j < WIN; ++j) s += prv[16 - j];
#pragma unroll
    for (int cb = 0; cb < 2; ++cb) {
#pragma unroll
        for (int i = 0; i < 16; ++i) { const int t = ts + 16 * cb + i; cur[i] = ld_row4(x, xb, (rowb + t) * DM + ch) * rs[t - t0 + 16]; }
#pragma unroll
        for (int i = 0; i < 16; ++i) { const int t = ts + 16 * cb + i;
            s += cur[i];
            const int cnt = (t + 1) < WIN ? (t + 1) : WIN; const f32x4 m = (s * (1.f / (float)cnt) - cur[i]) * gv;
            v2u o; o.x = pk2(m.x, m.y); o.y = pk2(m.z, m.w);
            *(GAS v2u*)(MB + ((size_t)g * M + rowb + t) * 256 + lane * 4) = o;
            const int oi = 16 + i - WIN + 1;
            s -= oi < 16 ? prv[oi] : cur[oi - 16]; }
#pragma unroll
        for (int i = 0; i < 16; ++i) prv[i] = cur[i];
    }
}
__device__ __forceinline__ void rows_ssq(const Frame& F, const float* x, float* ssq) {
    const int NGW = F.G * NWAVES, gw = F.vcu * NWAVES + F.wave;
    for (int m0 = gw * 4; m0 < M; m0 += NGW * 4) { f32x4 v[4][4]; float s[4];
#pragma unroll
        for (int r = 0; r < 4; ++r)
#pragma unroll
            for (int j = 0; j < 4; ++j) v[r][j] = ((const GAS f32x4*)(x + (size_t)(m0 + r) * DM))[F.lane + 64 * j];
#pragma unroll
        for (int r = 0; r < 4; ++r) { s[r] = 0.f;
#pragma unroll
            for (int j = 0; j < 4; ++j) s[r] += (v[r][j].x * v[r][j].x + v[r][j].y * v[r][j].y) + (v[r][j].z * v[r][j].z + v[r][j].w * v[r][j].w); }
#pragma unroll
        for (int o = 1; o < 64; o <<= 1)
#pragma unroll
            for (int r = 0; r < 4; ++r) s[r] += __builtin_bit_cast(float, __builtin_amdgcn_ds_bpermute((F.lane ^ o) << 2, __builtin_bit_cast(int, s[r])));
        if (F.lane < 4) { const float sv = F.lane == 0 ? s[0] : F.lane == 1 ? s[1] : F.lane == 2 ? s[2] : s[3]; ssq[m0 + F.lane] = sv; ssq[M + m0 + F.lane] = 0.f; ssq[2 * M + m0 + F.lane] = 0.f; ssq[3 * M + m0 + F.lane] = 0.f; } }
}
__device__ __forceinline__ void pool_prepass_unit(const Frame& F, int pm, int g, const float* x, const bf16* xb, const float* ssq, const float* gain, bf16* MB) {
    const int b = pm >> 3, t0 = (pm & 7) * 256; const size_t rowb = (size_t)b * SEQ;
    LAS float* rs = (LAS float*)F.lds;
    if (F.tid < 272) { const int t = t0 - 16 + F.tid; if (t >= 0) rs[F.tid] = row_rstd(ssq, (int)rowb + t); }
    LDS_WAIT(); __syncthreads();
    const int ts = t0 + 32 * F.wave;
    const f32x4 gv = *(const f32x4*)(gain + g * 256 + F.lane * 4);
    if (g == 0) pool_walk<2>(x, xb, rs, rowb, t0, ts, g, F.lane, gv, MB); else if (g == 1) pool_walk<4>(x, xb, rs, rowb, t0, ts, g, F.lane, gv, MB);
    else if (g == 2) pool_walk<8>(x, xb, rs, rowb, t0, ts, g, F.lane, gv, MB); else pool_walk<16>(x, xb, rs, rowb, t0, ts, g, F.lane, gv, MB);
    VM_WAIT(); __syncthreads();
}

struct MArgs { const float* in[19]; float* out; unsigned char* ws; int ph_lo, ph_hi, use_bar, li; float lam0, lam1; };
constexpr int N_PHASES = 18;
#ifndef DUP_TYPE
#define DUP_TYPE -1
#endif
enum { T_PRE = 0, T_POOL, T_MLPIN, T_MLPOUT, T_QKV, T_ATTN, T_OPROJ };
__host__ __device__ __forceinline__ int ph_type(int ph) { if (ph < 8) { const int s = ph & 3; return s == 0 ? T_PRE : s == 1 ? T_POOL : s == 2 ? T_MLPIN : T_MLPOUT; }
    const int s = (ph - 8) % 5; return s == 0 ? T_QKV : s == 1 ? T_ATTN : s == 2 ? T_OPROJ : s == 3 ? T_MLPIN : T_MLPOUT; }
__host__ __device__ __forceinline__ int ph_layer(int ph) { return ph < 8 ? ph / 4 : 2 + (ph - 8) / 5; }

__global__ void __launch_bounds__(NWAVES * 64, 2) mega(MArgs a) {
    extern __shared__ __attribute__((aligned(16))) unsigned char lds_raw[];
    Frame F; F.lds = (LAS unsigned char*)lds_raw; F.tid = threadIdx.x; F.lane = F.tid & 63; F.wave = __builtin_amdgcn_readfirstlane(F.tid >> 6);
    F.G = gridDim.x; { const int bx = blockIdx.x; F.vcu = (F.G % 8 == 0) ? (bx % 8) * (F.G / 8) + bx / 8 : bx; }
    volatile LAS unsigned* MISC = (volatile LAS unsigned*)(F.lds + MISC_OFF);
    unsigned char* ws0 = a.ws;
    for (int u = F.tid; u < (LDS_BYTES - LDSCTL_OFF) / 4; u += NWAVES * 64) ((LAS unsigned*)(F.lds + LDSCTL_OFF))[u] = 0u;
    __syncthreads();
    unsigned* barw = (unsigned*)(ws0 + WS_CTL) + CW_BAR + a.li * XCD_BAR_WORDS;
    XcdBarrier bar; bar.bar = barw; bar.x = 0; bar.st = nullptr;
    if (a.use_bar) bar = xcd_barrier_post(barw, MISC + 8, (unsigned)(F.vcu >> 5));

    for (int it = 2 * a.ph_lo; it < 2 * a.ph_hi; ++it) { const int ph = it >> 1, rep = it & 1;
        const int ty = ph_type(ph), l = ph_layer(ph);
        { int t_ = threadIdx.x; asm volatile("" : "+v"(t_)); F.tid = t_; F.lane = t_ & 63; F.wave = __builtin_amdgcn_readfirstlane(t_ >> 6); }
        size_t zz = 0; asm volatile("" : "+s"(zz));
            unsigned char* ws = a.ws + zz;
        const float* x0 = (a.in[0] + zz); const float* norm_mix = (a.in[1] + zz); const float* norm_mlp = (a.in[2] + zz); const float* pool_w = (a.in[3] + zz); const float* pool_scale = (a.in[4] + zz);
        const float* kv_norm = (a.in[5] + zz); const float* w_kv = (a.in[6] + zz); const float* k_norm = (a.in[7] + zz); const float* w_q = (a.in[9] + zz); const float* q_norm = (a.in[10] + zz);
        const float* rel_bias = (a.in[8] + zz); const float* lq1 = (a.in[11] + zz); const float* lk1 = (a.in[12] + zz); const float* lq2 = (a.in[13] + zz); const float* lk2 = (a.in[14] + zz); const float* subln = (a.in[15] + zz);
        const float* w_o = (a.in[16] + zz); const float* w_in = (a.in[17] + zz); const float* w_out = (a.in[18] + zz);
        float* X = a.out + zz; float* SSQ = (float*)(ws + WS_SSQ); float* SSQ2 = (float*)(ws + WS_SSQ2);
        bf16* WIN = (bf16*)(ws + WS_WIN); bf16* WOUT = (bf16*)(ws + WS_WOUT); bf16* WQKV = (bf16*)(ws + WS_WQKV); bf16* WQ1 = (bf16*)(ws + WS_WQ1); bf16* WO = (bf16*)(ws + WS_WO); bf16* POOL = (bf16*)(ws + WS_POOL);
        unsigned char* XB8 = ws + WS_K + 16 * MiB;
        float* CMAX = (float*)(ws + WS_CTL + 32768);
        bf16* XB = (bf16*)(ws + WS_XB); bf16* Kb = (bf16*)(ws + WS_K); bf16* Vb = (bf16*)(ws + WS_V); bf16* Ab = (bf16*)(ws + WS_A); bf16* Qb = (bf16*)(ws + WS_Q); bf16* Ob = (bf16*)(ws + WS_O); bf16* MB = (bf16*)(ws + WS_MB);
        if (rep == 0 && !(ty == DUP_TYPE && (ty == T_PRE || ty == T_MLPIN || ty == T_QKV || ty == T_ATTN))) continue;
        if (ty == T_PRE) {
            if (l == 1) {
                pg8::StaticOrder S; S.init(M, DM, F.G, (int)blockIdx.x); pg8::Unit u0; S.next(0, u0);
                pool_prepass_unit(F, u0.pm, u0.pn, nullptr, XB, SSQ2, norm_mix + l * DM, MB);
            } else {
                for (int i = 0; i < 8; ++i) conv_mat(F, pool_w + (size_t)i * 65536, 256, 256, nullptr, POOL + (size_t)i * 65536, i * 32);
                rows_ssq(F, x0, SSQ2);
            }
        } else if (ty == T_MLPIN) {
            pg8::Gemm g{XB, WIN, M, FF, DM, 0, 0}; pg8::StaticOrder S; S.init(M, FF, F.G, (int)blockIdx.x);
            pg8::EpiMlpIn E{Ab};
            pg8::gemm_phase<pg8::EpiMlpIn, pg8::StaticOrder, true, true>(F.lds, g, S, E, F.tid);
        } else if (ty == T_QKV) {
            const int N = l == 2 ? 3 * DM : DM;
            pg8::Gemm g{(const bf16*)XB8, l == 2 ? WQKV : WQ1, M, N, DM / 2, 0, 0}; pg8::StaticOrder S; S.init(M, N, F.G, (int)blockIdx.x);
            pg8::EpiQKV E{(unsigned char*)Qb, (unsigned char*)Kb, Vb, SSQ2, q_norm + (l - 2) * 64, k_norm, 0, SSQ, CMAX + (l == 2 ? 0 : 96)};
            pg8::gemm_phase<pg8::EpiQKV, pg8::StaticOrder, true, true, true>(F.lds, g, S, E, F.tid);
        } else if (ty == T_ATTN) {
            const int j = l - 2;
            attn::Params AP{(const unsigned char*)Qb, (const unsigned char*)Kb, Vb, Ob, rel_bias, lq1 + j * 64, lk1 + j * 64, lq2 + j * 64, lk2 + j * 64, subln + j * 128, j == 0 ? a.lam0 : a.lam1};
            attn::attn_phase(AP, F.lds, F.tid, F.vcu);
        } else {
            pg8::Gemm g; pg8::EpiResid E;
            pg8::StaticOrder S; S.init(M, DM, F.G, (int)blockIdx.x);
            if (ty == T_POOL) { if (l == 0) { pg8::Unit u0; S.next(0, u0); pool_prepass_unit(F, u0.pm, u0.pn, x0, XB, SSQ2, norm_mix, MB); }
                g = pg8::Gemm{MB, POOL + (size_t)l * 4 * 65536, M, DM, 256, (size_t)M * 256 * 2, 0}; E = pg8::EpiResid{l == 0 ? x0 : nullptr, nullptr, XB, pool_scale + l * DM, SSQ, nullptr}; }
            else if (ty == T_MLPOUT) {
                g = pg8::Gemm{Ab, WOUT, M, DM, FF, 0, 0}; E = pg8::EpiResid{nullptr, l == 3 ? X : nullptr, XB, nullptr, SSQ2, SSQ, (l == 1 || l == 2) ? XB8 : nullptr}; }
            else { g = pg8::Gemm{Ob, WO + (size_t)(l - 2) * DM * DM, M, DM, DM, 0, QO_BGAP * 2}; E = pg8::EpiResid{nullptr, nullptr, XB, nullptr, SSQ, nullptr}; }
            pg8::gemm_phase<pg8::EpiResid, pg8::StaticOrder, false, true>(F.lds, g, S, E, F.tid);
        }
        if (rep == 0) __syncthreads();
        else if (ph + 1 < a.ph_hi) {
            const bool loc_seam = MISC[13] != 0u && ((0x15AD0u >> ph) & 1u) != 0u;
            xcd_barrier_arrive(bar, loc_seam);
            if (ty == T_MLPOUT && l == 0) conv_mat(F, w_in + (size_t)DM * FF, DM, FF, norm_mlp + DM, WIN, 0);
            if (ty == T_PRE && l == 1) conv_mat(F, w_out + (size_t)DM * FF, FF, DM, nullptr, WOUT, 0);
            if (ty == T_ATTN) { conv_mat(F, w_in + (size_t)l * DM * FF, DM, FF, norm_mlp + l * DM, WIN, 0); conv_mat(F, w_out + (size_t)l * DM * FF, FF, DM, nullptr, WOUT, 1024); }
            if (ph == 0) conv_mat(F, w_in, DM, FF, norm_mlp, WIN, 0);
            if (ph == 1) { conv_mat(F, w_out, FF, DM, nullptr, WOUT, 0); conv_colmax(F, w_q, DM, DM, norm_mix + 2 * DM, CMAX, 1024); conv_colmax(F, w_kv, DM, 2 * DM, kv_norm, CMAX + 32, 1536); }
            if (ph == 2) { conv_mat_i8(F, w_q, DM, DM, norm_mix + 2 * DM, CMAX, (unsigned char*)WQKV, 0); conv_mat_i8(F, w_kv, DM, 2 * DM, kv_norm, CMAX + 32, (unsigned char*)WQKV + (size_t)DM * DM, 512); }
            if (ph == 5) { conv_mat(F, w_o, DM, DM, nullptr, WO, 0); conv_colmax(F, w_q + (size_t)DM * DM, DM, DM, norm_mix + 3 * DM, CMAX + 96, 1024); }
            if (ty == T_ATTN && l == 2) { conv_mat_i8(F, w_q + (size_t)DM * DM, DM, DM, norm_mix + 3 * DM, CMAX + 96, (unsigned char*)WQ1, 0); conv_mat(F, w_o + (size_t)DM * DM, DM, DM, nullptr, WO + (size_t)DM * DM, 512); }
            xcd_barrier_wait(bar);
            if (ph == a.ph_lo) xcd_barrier_check_regular(bar, 8u, 32u);
        }
    }
}

extern "C" void kernel_launch(void* const* d_in, const int* in_sizes, int n_in, void* d_out, int out_size, void* d_ws, size_t ws_size, hipStream_t stream) {
    static int ready = 0;
    if (!ready) { ready = 1;
        int dev = 0, cus = 0, per_cu = 0;
        (void)hipFuncSetAttribute((const void*)mega, hipFuncAttributeMaxDynamicSharedMemorySize, LDS_BYTES);
        if (hipGetDevice(&dev) != hipSuccess || hipDeviceGetAttribute(&cus, hipDeviceAttributeMultiprocessorCount, dev) != hipSuccess) cus = 0;
        if (hipOccupancyMaxActiveBlocksPerMultiprocessor(&per_cu, (const void*)mega, NWAVES * 64, LDS_BYTES) != hipSuccess) per_cu = 0;
        (void)hipGetLastError();
        if (cus != 256 || per_cu < 1) fprintf(stderr, "kernel_launch: built for 256 CUs with one resident workgroup each; this device reports %d CUs, %d workgroups per CU\n", cus, per_cu);
    }
    (void)hipMemsetAsync((char*)d_ws + WS_CTL, 0, CTL_ZERO_BYTES, stream);
    MArgs a{};
    for (int i = 0; i < 19; ++i) a.in[i] = (const float*)d_in[i];
    a.out = (float*)d_out; a.ws = (unsigned char*)d_ws;
    a.lam0 = (float)(0.8 - 0.6 * exp(-0.3 * 2.0)); a.lam1 = (float)(0.8 - 0.6 * exp(-0.3 * 3.0));
    a.ph_lo = 0; a.ph_hi = N_PHASES; a.use_bar = 1; a.li = 0;
    hipLaunchKernelGGL(mega, dim3(256), dim3(NWAVES * 64), LDS_BYTES, stream, a);
}
```

```cpp
#include <hip/hip_runtime.h>
#include <cstdint>
#include <cmath>
#include <cstdio>

typedef unsigned short bf16;
constexpr int BATCH = 8, SEQ = 2048, DM = 1024, M = BATCH * SEQ, FF = 4096, NH = 8, HD = 64, VD = 128;
constexpr float EPS = 1e-6f;
constexpr float LOG2E = 1.4426950408889634f;

__device__ __forceinline__ unsigned f2bf(float f) { unsigned u = __float_as_uint(f); return (u + 0x7fffu + ((u >> 16) & 1u)) >> 16; }
__device__ __forceinline__ float bf2f(unsigned h) { return __uint_as_float(h << 16); }
__device__ __forceinline__ unsigned pk2(float lo, float hi) { return f2bf(lo) | (f2bf(hi) << 16); }

constexpr size_t MiB = 1u << 20;
constexpr size_t WS_CTL = 0, CTL_ZERO_BYTES = 64 * 1024;
constexpr size_t WS_SSQ = MiB / 2, WS_SSQ2 = 3 * MiB / 4;
constexpr size_t WS_WIN = 1 * MiB;
constexpr size_t WS_WOUT = 9 * MiB;
constexpr size_t WS_WQKV = 17 * MiB;
constexpr size_t WS_WQ1 = 23 * MiB;
constexpr size_t WS_WO = 25 * MiB;
constexpr size_t WS_POOL = 29 * MiB;
constexpr size_t WS_XB = 32 * MiB;
constexpr size_t WS_K = 64 * MiB, WS_V = 96 * MiB;
constexpr size_t WS_A = 128 * MiB;
constexpr size_t WS_Q = 128 * MiB, WS_O = 132 * MiB, WS_MB = 192 * MiB;
constexpr size_t Q8_BGAP = 14 * MiB;
constexpr size_t QO_BGAP = 6 * MiB;
constexpr int CW_BAR = 4096;

__device__ __forceinline__ float row_rstd(const float* ssq, int row) { return rsqrtf((ssq[row] + ssq[M + row] + ssq[2 * M + row] + ssq[3 * M + row]) * (1.f / DM) + EPS); }
__device__ __forceinline__ float wave_max(float v) { for (int o = 1; o < 64; o <<= 1) v = fmaxf(v, __shfl_xor(v, o)); return v; }
__device__ __forceinline__ float wave_sum(float v) { for (int o = 1; o < 64; o <<= 1) v += __shfl_xor(v, o); return v; }
__device__ __forceinline__ int t5_bucket(int rel) {
    if (rel < 16) return rel;
    int l = 16 + (int)(logf((float)rel / 16.f) / logf(8.f) * 16.f);
    return l < 31 ? l : 31;
}
namespace pg8 {
#define PG8_LAS __attribute__((address_space(3)))
typedef unsigned short bf16_t;
typedef short bf16x8 __attribute__((ext_vector_type(8)));
typedef float f32x4 __attribute__((ext_vector_type(4)));
typedef unsigned u32x4 __attribute__((ext_vector_type(4)));
constexpr int BM = 256, BK = 64, HALF = 128, HTB = HALF * BK * 2  , STAGE_BYTES = 8 * HTB, NXCD = 8, WGM = 8;

__host__ __device__ __forceinline__ int lds_byte(int r, int c) { const int st = (r >> 4) * 2 + (c >> 5), rr = r & 15, cc = c & 31, ob = rr * 64 + cc * 2; return st * 1024 + (ob ^ (((ob >> 9) & 1) << 5)); }
__host__ __device__ __forceinline__ void stage_rc(int b, int& R, int& C) { const int st = b / 1024, sb = b % 1024, swz = sb ^ (((sb >> 9) & 1) << 5); R = (st >> 1) * 16 + swz / 64; C = (st & 1) * 32 + (swz % 64) / 2; }
__host__ __device__ __forceinline__ int perm32(int rho) { const int n = rho >> 4, i = rho & 15; return 8 * (i >> 2) + 4 * n + (i & 3); }

struct Unit { int pm, pn; };
struct Gemm { const bf16_t* A; const bf16_t* Bt; int M, N, K; size_t a_grp, a_bat; };

struct StaticOrder {
    int nM, nN, nwg, G, c;
    __host__ __device__ __forceinline__ void init(int M, int N, int G_, int c_) { nM = M / BM; nN = N / BM; nwg = nM * nN; G = G_; c = c_; }
    __host__ __device__ __forceinline__ bool next(int i, Unit& u) const {
        const long L = (long)i * G + c; if (L >= nwg) return false;
        int wgid = (int)L; { const int q = nwg / NXCD, r = nwg % NXCD, xcd = wgid % NXCD, off = wgid / NXCD; wgid = (xcd < r ? xcd * (q + 1) : r * (q + 1) + (xcd - r) * q) + off; }
        const int nig = WGM * nN, gid = wgid / nig, fm = gid * WGM, gsz = (nM - fm) < WGM ? (nM - fm) : WGM;
        u.pm = fm + ((wgid % nig) % gsz); u.pn = (wgid % nig) / gsz; return true;
    }
    __device__ __forceinline__ void a_ready(const Unit&) const {}
    __device__ __forceinline__ void done(const Unit&) const {}
};

__device__ __forceinline__ unsigned cvt_pk_bf16(float lo, float hi) { unsigned r; asm volatile("v_cvt_pk_bf16_f32 %0, %1, %2" : "=v"(r) : "v"(lo), "v"(hi)); return r; }
__device__ __forceinline__ float rstd_of(const float* ssq, int row) { return rsqrtf((ssq[row] + ssq[::M + row] + ssq[2 * ::M + row] + ssq[3 * ::M + row]) * (1.f / ::DM) + ::EPS); }

struct EpiMlpIn {
    static constexpr bool PERM = true, AFTER_DRAIN = false, HEADPERM = false;
    bf16_t* O; const float* colmax;
    __device__ __forceinline__ void operator()(const f32x4 (&acc)[2][2][4][2], const Unit& u, int wr, int wc, int fr, int fq) const {
        const int row0 = u.pm * BM + wr * 64 + fr, col0 = u.pn * BM + wc * 32 + 8 * fq;
        const float sc0 = colmax ? colmax[u.pn * 8 + wc] * (1.f / 127.f) : 0.f, sc1 = colmax ? colmax[u.pn * 8 + 4 + wc] * (1.f / 127.f) : 0.f;
#pragma unroll
        for (int ai = 0; ai < 2; ++ai)
#pragma unroll
            for (int m = 0; m < 4; ++m) { const int row = row0 + ai * HALF + m * 16; bf16_t* rowp = O + (size_t)row * ::FF + col0;
#pragma unroll
                for (int bj = 0; bj < 2; ++bj) { typedef int v4i_ __attribute__((ext_vector_type(4))); const v4i_ i0 = __builtin_bit_cast(v4i_, acc[ai][bj][m][0]), i1 = __builtin_bit_cast(v4i_, acc[ai][bj][m][1]); const float sc = bj ? sc1 : sc0;
                    f32x4 v0 = colmax ? (f32x4){(float)i0[0], (float)i0[1], (float)i0[2], (float)i0[3]} * sc : acc[ai][bj][m][0], v1 = colmax ? (f32x4){(float)i1[0], (float)i1[1], (float)i1[2], (float)i1[3]} * sc : acc[ai][bj][m][1];
#pragma unroll
                    for (int e = 0; e < 4; ++e) { v0[e] = fmaxf(v0[e] * __builtin_fabsf(v0[e]), 0.f); v1[e] = fmaxf(v1[e] * __builtin_fabsf(v1[e]), 0.f); }
                    u32x4 w; w.x = cvt_pk_bf16(v0[0], v0[1]); w.y = cvt_pk_bf16(v0[2], v0[3]); w.z = cvt_pk_bf16(v1[0], v1[1]); w.w = cvt_pk_bf16(v1[2], v1[3]);
                    *(u32x4*)(rowp + bj * HALF) = w; } }
    }
};

struct EpiQKV {
    static constexpr bool PERM = true, AFTER_DRAIN = false, HEADPERM = true;
    unsigned char* q; unsigned char* k; bf16_t* v; const float* ssq; const float* qn; const float* kn; int part0; const float* ssq_old; const float* colmax;
    __device__ __forceinline__ void operator()(const f32x4 (&acc)[2][2][4][2], const Unit& u, int wr, int wc, int fr, int fq) const {
        const int part = part0 + (u.pn >> 2), seg = (u.pn & 3) * 4 + wc;
        bf16_t* dst = v + seg * 64 + 8 * fq; unsigned char* dst8 = (part == 0 ? q + (size_t)(u.pm >> 3) * ::Q8_BGAP : k) + seg * 64 + 8 * fq;
        const float* gw = part == 0 ? qn : kn; const float gs = part == 0 ? ::LOG2E : 1.f;
        const int row0 = u.pm * BM + wr * 64 + fr;
        const float sc0 = colmax[u.pn * 8 + wc * 2] * (1.f / 127.f), sc1 = colmax[u.pn * 8 + wc * 2 + 1] * (1.f / 127.f);
        float rs[2][4];
#pragma unroll
        for (int ai = 0; ai < 2; ++ai)
#pragma unroll
            for (int m = 0; m < 4; ++m) rs[ai][m] = rstd_of(ssq, row0 + ai * HALF + m * 16) * (8.f / 127.f) / rstd_of(ssq_old, row0 + ai * HALF + m * 16);
#pragma unroll
        for (int ai = 0; ai < 2; ++ai)
#pragma unroll
            for (int m = 0; m < 4; ++m) { const int row = row0 + ai * HALF + m * 16; const float r = rs[ai][m];
                f32x4 x[2][2]; float s = 0.f;
#pragma unroll
                for (int bj = 0; bj < 2; ++bj)
#pragma unroll
                    for (int n = 0; n < 2; ++n) { typedef int v4i_ __attribute__((ext_vector_type(4))); const v4i_ ai_ = __builtin_bit_cast(v4i_, acc[ai][bj][m][n]);
                        x[bj][n] = (f32x4){(float)ai_[0], (float)ai_[1], (float)ai_[2], (float)ai_[3]} * (r * (bj ? sc1 : sc0)); const f32x4 t = x[bj][n] * x[bj][n]; s += (t[0] + t[1]) + (t[2] + t[3]); }
                s += __shfl_xor(s, 16); s += __shfl_xor(s, 32);
                const float hr = part < 2 ? rsqrtf(s * (1.f / 64.f) + ::EPS) : 1.f;
#pragma unroll
                for (int bj = 0; bj < 2; ++bj) { const f32x4 one_ = {1.f, 1.f, 1.f, 1.f};
                    const f32x4 w0 = part < 2 ? *(const f32x4*)(gw + 32 * bj + 8 * fq) * gs : one_, w1 = part < 2 ? *(const f32x4*)(gw + 32 * bj + 8 * fq + 4) * gs : one_;
                    const f32x4 y0 = x[bj][0] * hr * w0, y1 = x[bj][1] * hr * w1;
                    if (part < 2) { int lo = __builtin_amdgcn_cvt_pk_fp8_f32(y0[0], y0[1], 0, false); lo = __builtin_amdgcn_cvt_pk_fp8_f32(y0[2], y0[3], lo, true);
                        int hi = __builtin_amdgcn_cvt_pk_fp8_f32(y1[0], y1[1], 0, false); hi = __builtin_amdgcn_cvt_pk_fp8_f32(y1[2], y1[3], hi, true);
                        typedef int i32x2_ __attribute__((ext_vector_type(2))); *(i32x2_*)(dst8 + (size_t)row * 1024 + 32 * bj) = (i32x2_){lo, hi}; }
                    else { u32x4 o; o.x = cvt_pk_bf16(y0[0], y0[1]); o.y = cvt_pk_bf16(y0[2], y0[3]); o.z = cvt_pk_bf16(y1[0], y1[1]); o.w = cvt_pk_bf16(y1[2], y1[3]);
                        *(u32x4*)(dst + (size_t)row * ::DM + 32 * bj) = o; } } }
    }
};

struct EpiResid {
    static constexpr bool PERM = true, AFTER_DRAIN = true, HEADPERM = false;
    const float* xin_f32; float* xout_f32; bf16_t* xb; const float* scale; float* ssq; const float* rsq_in; unsigned char* xq = nullptr; const float* srow = nullptr;
    __device__ __forceinline__ void fused(f32x4 (&acc)[2][2][4][2], const Unit& u, int wr, int wc, int fr, int fq, PG8_LAS unsigned char* lds, int wid, int lane) const {
        PG8_LAS float* P = (PG8_LAS float*)lds;
        const int col0 = u.pn * BM + wc * 32 + 8 * fq;
        if (rsq_in) {
#pragma unroll
            for (int ai = 0; ai < 2; ++ai)
#pragma unroll
                for (int m = 0; m < 4; ++m) { const int rr_ = u.pm * BM + ai * HALF + wr * 64 + m * 16 + fr; const float r = rstd_of(rsq_in, rr_) * (srow ? srow[rr_] : 1.f), r2 = r * r;
#pragma unroll
                    for (int bj = 0; bj < 2; ++bj)
#pragma unroll
                        for (int n = 0; n < 2; ++n) acc[ai][bj][m][n] *= r2; }
        }
        if (scale) {
#pragma unroll
            for (int bj = 0; bj < 2; ++bj)
#pragma unroll
                for (int n = 0; n < 2; ++n) { const f32x4 sv = *(const f32x4*)(scale + col0 + bj * HALF + n * 4);
#pragma unroll
                    for (int ai = 0; ai < 2; ++ai)
#pragma unroll
                        for (int m = 0; m < 4; ++m) acc[ai][bj][m][n] *= sv; }
        }
#pragma unroll
        for (int ai = 0; ai < 2; ++ai) {
            u32x4 xr[4][2]; f32x4 xf[4][2][2];
            if (xin_f32) {
#pragma unroll
                for (int m = 0; m < 4; ++m)
#pragma unroll
                    for (int bj = 0; bj < 2; ++bj) { const float* p = xin_f32 + (size_t)(u.pm * BM + ai * HALF + wr * 64 + m * 16 + fr) * ::DM + col0 + bj * HALF; xf[m][bj][0] = *(const f32x4*)p; xf[m][bj][1] = *(const f32x4*)(p + 4); }
            } else {
#pragma unroll
                for (int m = 0; m < 4; ++m)
#pragma unroll
                    for (int bj = 0; bj < 2; ++bj) xr[m][bj] = *(const u32x4*)(xb + (size_t)(u.pm * BM + ai * HALF + wr * 64 + m * 16 + fr) * ::DM + col0 + bj * HALF);
#pragma unroll
                for (int m = 0; m < 4; ++m)
#pragma unroll
                    for (int bj = 0; bj < 2; ++bj) { const u32x4 w = xr[m][bj];
                        xf[m][bj][0] = (f32x4){__uint_as_float(w.x << 16), __uint_as_float(w.x & 0xffff0000u), __uint_as_float(w.y << 16), __uint_as_float(w.y & 0xffff0000u)};
                        xf[m][bj][1] = (f32x4){__uint_as_float(w.z << 16), __uint_as_float(w.z & 0xffff0000u), __uint_as_float(w.w << 16), __uint_as_float(w.w & 0xffff0000u)}; }
            }
#pragma unroll
            for (int m = 0; m < 4; ++m) { const int r = ai * HALF + wr * 64 + m * 16 + fr; const size_t off = (size_t)(u.pm * BM + r) * ::DM + col0; float s = 0.f;
                const float qinv = xq ? (127.f / 8.f) * rstd_of(rsq_in, u.pm * BM + r) : 0.f;
#pragma unroll
                for (int bj = 0; bj < 2; ++bj) { const f32x4 y0 = xf[m][bj][0] + acc[ai][bj][m][0], y1 = xf[m][bj][1] + acc[ai][bj][m][1];
                    u32x4 w; w.x = cvt_pk_bf16(y0[0], y0[1]); w.y = cvt_pk_bf16(y0[2], y0[3]); w.z = cvt_pk_bf16(y1[0], y1[1]); w.w = cvt_pk_bf16(y1[2], y1[3]);
                    *(u32x4*)(xb + off + bj * HALF) = w;
                    if (xq) { unsigned t_[8];
#pragma unroll
                        for (int i = 0; i < 4; ++i) { t_[i] = __float_as_uint(__builtin_amdgcn_fmed3f(y0[i] * qinv, -127.f, 127.f) + 12582912.f); t_[4 + i] = __float_as_uint(__builtin_amdgcn_fmed3f(y1[i] * qinv, -127.f, 127.f) + 12582912.f); }
                        typedef unsigned u32x2_ __attribute__((ext_vector_type(2))); u32x2_ o8;
                        o8.x = __builtin_amdgcn_perm(t_[1], t_[0], 0x0c0c0400u) | __builtin_amdgcn_perm(t_[3], t_[2], 0x04000c0cu);
                        o8.y = __builtin_amdgcn_perm(t_[5], t_[4], 0x0c0c0400u) | __builtin_amdgcn_perm(t_[7], t_[6], 0x04000c0cu);
                        *(u32x2_*)(xq + off + bj * HALF) = o8; }
                    if (xout_f32) { *(f32x4*)(xout_f32 + off + bj * HALF) = y0; *(f32x4*)(xout_f32 + off + bj * HALF + 4) = y1; }
                    const f32x4 t0 = y0 * y0, t1 = y1 * y1; s += ((t0[0] + t0[1]) + (t0[2] + t0[3])) + ((t1[0] + t1[1]) + (t1[2] + t1[3])); }
                s += __shfl_xor(s, 16); s += __shfl_xor(s, 32);
                if (fq == 0) P[r * 4 + wc] = s; }
            asm volatile("" ::: "memory");
        }
        asm volatile("s_waitcnt lgkmcnt(0)" ::: "memory"); __builtin_amdgcn_s_barrier(); asm volatile("" ::: "memory");
        const int t = wid * 64 + lane;
        if (t < 256) ssq[(size_t)u.pn * ::M + u.pm * BM + t] = (P[t * 4 + 0] + P[t * 4 + 1]) + (P[t * 4 + 2] + P[t * 4 + 3]);
    }
};

template <class Epi, class Sched, bool ALIGN_EPI = false, bool SP2 = false, bool I8 = false>
__device__ __forceinline__ void gemm_phase(PG8_LAS unsigned char* lds, const Gemm g, const Sched& S, const Epi& E, const int tid) {
    const int wid = __builtin_amdgcn_readfirstlane(tid >> 6), lane = tid & 63, wr = wid >> 2, wc = wid & 3, fr = lane & 15, fq = lane >> 4;
    const int K = g.K, nt = K / BK;
    unsigned voffA[2], voffB[2];
#pragma unroll
    for (int i = 0; i < 2; ++i) { int R, C; stage_rc(tid * 16 + i * 8192, R, C); const int Rb = Epi::HEADPERM ? ((R >> 5) * 64 + perm32(R & 31)) : (Epi::PERM ? ((R & ~31) + perm32(R & 31)) : R);
        voffA[i] = (unsigned)(R * K + C) * 2u; voffB[i] = (unsigned)(Rb * K + C) * 2u; }
    const size_t kstep = (size_t)(BK * 2);
    const size_t hstep = (size_t)HALF * K * 2;
    const size_t tstep = 2 * hstep; const size_t hstepB = Epi::HEADPERM ? (size_t)32 * K * 2 : hstep;
    const unsigned ldsw = (unsigned)wid * 1024u;
    const int aoff = lds_byte(wr * 64 + fr, fq * 8), boff = lds_byte(wc * 32 + fr, fq * 8);
#define PG8_SA(b, h) (((b) * 2 + (h)) * HTB)
#define PG8_SB(b, h) ((4 + (b) * 2 + (h)) * HTB)
#define PG8_STAGE(bufoff, gbase, voff) do { _Pragma("unroll") for (int _i = 0; _i < 2; ++_i) \
        __builtin_amdgcn_global_load_lds((const unsigned*)((const char*)(gbase) + (voff)[_i]), (PG8_LAS unsigned*)(lds + (bufoff) + ldsw + _i * 8192), 16, 0, 0); } while (0)
#define PG8_LDA(dst, b, h) do { _Pragma("unroll") for (int m = 0; m < 4; ++m) _Pragma("unroll") for (int k = 0; k < 2; ++k) dst[m][k] = *(const PG8_LAS bf16x8*)(lds + PG8_SA(b, h) + aoff + m * 2048 + k * 1024); } while (0)
#define PG8_LDB(dst, b, h) do { _Pragma("unroll") for (int n = 0; n < 2; ++n) _Pragma("unroll") for (int k = 0; k < 2; ++k) dst[n][k] = *(const PG8_LAS bf16x8*)(lds + PG8_SB(b, h) + boff + n * 2048 + k * 1024); } while (0)
#define PG8_MMA(ai, bj, At, Bt) do { __builtin_amdgcn_s_setprio(1); _Pragma("unroll") for (int m = 0; m < 4; ++m) _Pragma("unroll") for (int n = 0; n < 2; ++n) _Pragma("unroll") for (int k = 0; k < 2; ++k) \
        { if constexpr (I8) { typedef int v4i_ __attribute__((ext_vector_type(4))); acc[ai][bj][m][n] = __builtin_bit_cast(f32x4, __builtin_amdgcn_mfma_i32_16x16x64_i8(__builtin_bit_cast(v4i_, Bt[n][k]), __builtin_bit_cast(v4i_, At[m][k]), __builtin_bit_cast(v4i_, acc[ai][bj][m][n]), 0, 0, 0)); } \
          else acc[ai][bj][m][n] = __builtin_amdgcn_mfma_f32_16x16x32_bf16(Bt[n][k], At[m][k], acc[ai][bj][m][n], 0, 0, 0); } __builtin_amdgcn_s_setprio(0); } while (0)
#define PG8_WAIT_V(n) asm volatile("s_waitcnt vmcnt(" #n ")" ::: "memory")
#define PG8_WAIT_L(n) asm volatile("s_waitcnt lgkmcnt(" #n ")" ::: "memory")
#define PG8_BAR __builtin_amdgcn_s_barrier()
#define PG8_SCHED __builtin_amdgcn_sched_barrier(0)
    Unit cur, nxt; int ui = 0;
    if (!S.next(0, cur)) return;
    f32x4 acc[2][2][4][2];
#pragma unroll
    for (int a = 0; a < 2; ++a)
#pragma unroll
        for (int b = 0; b < 2; ++b)
#pragma unroll
            for (int m = 0; m < 4; ++m)
#pragma unroll
                for (int n = 0; n < 2; ++n) acc[a][b][m][n] = (f32x4){0.f, 0.f, 0.f, 0.f};
    bf16x8 At[4][2], B0[2][2], B1[2][2];
    const char* cA = (const char*)g.A + (size_t)cur.pm * tstep + (size_t)cur.pn * g.a_grp + (size_t)(cur.pm >> 3) * g.a_bat; const char* cB = (const char*)g.Bt + (size_t)cur.pn * tstep;
    S.a_ready(cur);
    if constexpr (SP2) {
        PG8_STAGE(PG8_SB(0, 0), cB, voffB); PG8_STAGE(PG8_SB(0, 1), cB + hstepB, voffB); PG8_STAGE(PG8_SA(0, 0), cA, voffA); PG8_STAGE(PG8_SA(0, 1), cA + hstep, voffA);
        if (wr == 1) PG8_BAR;
        PG8_WAIT_V(2); PG8_BAR;
        PG8_STAGE(PG8_SB(1, 0), cB + kstep, voffB); PG8_STAGE(PG8_SA(1, 0), cA + kstep, voffA); PG8_STAGE(PG8_SB(1, 1), cB + hstepB + kstep, voffB);
        PG8_WAIT_V(6); PG8_BAR;
    } else {
        PG8_STAGE(PG8_SB(0, 0), cB, voffB); PG8_STAGE(PG8_SA(0, 0), cA, voffA); PG8_STAGE(PG8_SB(0, 1), cB + hstepB, voffB); PG8_STAGE(PG8_SA(0, 1), cA + hstep, voffA);
        if (wr == 1) PG8_BAR;
        PG8_WAIT_V(4); PG8_BAR;
        PG8_STAGE(PG8_SB(1, 0), cB + kstep, voffB); PG8_STAGE(PG8_SA(1, 0), cA + kstep, voffA); PG8_STAGE(PG8_SB(1, 1), cB + hstepB + kstep, voffB);
        PG8_WAIT_V(6); PG8_BAR;
    }
    for (;;) {
        const bool has_next = S.next(ui + 1, nxt);
        const char* nA = has_next ? (const char*)g.A + (size_t)nxt.pm * tstep + (size_t)nxt.pn * g.a_grp + (size_t)(nxt.pm >> 3) * g.a_bat : cA; const char* nB = has_next ? (const char*)g.Bt + (size_t)nxt.pn * tstep : cB;
        for (int t = 0; t < nt; t += 2) {
            const bool last = (t == nt - 2);
            const char* a1 = cA + (size_t)(t + 1) * kstep;
            const char* a2 = last ? nA : cA + (size_t)(t + 2) * kstep; const char* b2 = last ? nB : cB + (size_t)(t + 2) * kstep;
            const char* a3 = a2 + kstep; const char* b3 = b2 + kstep;
            if (last && has_next) S.a_ready(nxt);
            if constexpr (SP2) {
            PG8_LDB(B0, 0, 0); PG8_LDB(B1, 0, 1); PG8_SCHED; PG8_LDA(At, 0, 0); PG8_STAGE(PG8_SA(1, 1), a1 + hstep, voffA);
            PG8_WAIT_V(8); PG8_WAIT_L(0); PG8_BAR; PG8_MMA(0, 0, At, B0); PG8_MMA(0, 1, At, B1); PG8_BAR; PG8_SCHED;
            PG8_LDA(At, 0, 1); PG8_STAGE(PG8_SB(0, 0), b2, voffB); PG8_STAGE(PG8_SB(0, 1), b2 + hstepB, voffB); PG8_STAGE(PG8_SA(0, 0), a2, voffA);
            PG8_WAIT_V(8); PG8_WAIT_L(0); PG8_BAR; PG8_MMA(1, 0, At, B0); PG8_MMA(1, 1, At, B1); PG8_BAR; PG8_SCHED;
            PG8_LDB(B0, 1, 0); PG8_LDB(B1, 1, 1); PG8_SCHED; PG8_LDA(At, 1, 0); PG8_STAGE(PG8_SA(0, 1), a2 + hstep, voffA);
            PG8_WAIT_V(8); PG8_WAIT_L(0); PG8_BAR; PG8_MMA(0, 0, At, B0); PG8_MMA(0, 1, At, B1); PG8_BAR; PG8_SCHED;
            PG8_LDA(At, 1, 1); PG8_STAGE(PG8_SB(1, 0), b3, voffB); PG8_STAGE(PG8_SB(1, 1), b3 + hstepB, voffB); PG8_STAGE(PG8_SA(1, 0), a3, voffA);
            PG8_WAIT_V(8); PG8_WAIT_L(0); PG8_BAR; PG8_MMA(1, 0, At, B0); PG8_MMA(1, 1, At, B1); PG8_BAR; PG8_SCHED;
            } else {
            PG8_LDB(B0, 0, 0); PG8_SCHED; PG8_LDA(At, 0, 0); PG8_STAGE(PG8_SA(1, 1), a1 + hstep, voffA);
            PG8_WAIT_L(8); PG8_BAR; PG8_WAIT_L(0); PG8_MMA(0, 0, At, B0); PG8_BAR; PG8_SCHED;
            PG8_LDB(B1, 0, 1); PG8_STAGE(PG8_SB(0, 0), b2, voffB);
            PG8_BAR; PG8_WAIT_L(0); PG8_MMA(0, 1, At, B1); PG8_BAR;
            PG8_LDA(At, 0, 1); PG8_STAGE(PG8_SA(0, 0), a2, voffA);
            PG8_BAR; PG8_WAIT_L(0); PG8_MMA(1, 0, At, B0); PG8_BAR; PG8_SCHED;
            PG8_STAGE(PG8_SB(0, 1), b2 + hstepB, voffB);
            PG8_WAIT_V(6); PG8_BAR; PG8_MMA(1, 1, At, B1); PG8_BAR;
            PG8_LDB(B0, 1, 0); PG8_SCHED; PG8_LDA(At, 1, 0); PG8_STAGE(PG8_SA(0, 1), a2 + hstep, voffA);
            PG8_WAIT_L(8); PG8_BAR; PG8_WAIT_L(0); PG8_MMA(0, 0, At, B0); PG8_BAR; PG8_SCHED;
            PG8_LDB(B1, 1, 1); PG8_STAGE(PG8_SB(1, 0), b3, voffB);
            PG8_BAR; PG8_WAIT_L(0); PG8_MMA(0, 1, At, B1); PG8_BAR;
            PG8_LDA(At, 1, 1); PG8_STAGE(PG8_SA(1, 0), a3, voffA);
            PG8_BAR; PG8_WAIT_L(0); PG8_MMA(1, 0, At, B0); PG8_BAR; PG8_SCHED;
            PG8_STAGE(PG8_SB(1, 1), b3 + hstepB, voffB);
            PG8_WAIT_V(6); PG8_BAR; PG8_MMA(1, 1, At, B1); PG8_BAR;
            }
        }
        if constexpr (ALIGN_EPI) { if (wr == 0) PG8_BAR; }
        if constexpr (!Epi::AFTER_DRAIN) { E(acc, cur, wr, wc, fr, fq); S.done(cur); }
        if (!has_next) break;
#pragma unroll
        for (int a = 0; a < 2; ++a)
#pragma unroll
            for (int b = 0; b < 2; ++b)
#pragma unroll
                for (int m = 0; m < 4; ++m)
#pragma unroll
                    for (int n = 0; n < 2; ++n) acc[a][b][m][n] = (f32x4){0.f, 0.f, 0.f, 0.f};
        cur = nxt; cA = nA; cB = nB; ++ui;
        if constexpr (ALIGN_EPI) { if (wr == 1) PG8_BAR; }
    }
    PG8_WAIT_V(0);
    if constexpr (!ALIGN_EPI) { if (wr == 0) PG8_BAR; }
    PG8_BAR;
    if constexpr (Epi::AFTER_DRAIN) { E.fused(acc, cur, wr, wc, fr, fq, lds, wid, lane); S.done(cur); }
#undef PG8_SA
#undef PG8_SB
#undef PG8_STAGE
#undef PG8_LDA
#undef PG8_LDB
#undef PG8_MMA
#undef PG8_WAIT_V
#undef PG8_WAIT_L
#undef PG8_BAR
#undef PG8_SCHED
}
}
#define GAS __attribute__((address_space(1)))
#define LAS __attribute__((address_space(3)))
typedef unsigned v4u __attribute__((ext_vector_type(4)));
typedef unsigned v2u __attribute__((ext_vector_type(2)));
typedef float f32x4 __attribute__((ext_vector_type(4)));
typedef GAS unsigned gu32;
#define LDS_WAIT() asm volatile("s_waitcnt lgkmcnt(0)" ::: "memory")
#define VM_WAIT() asm volatile("s_waitcnt vmcnt(0)" ::: "memory")
constexpr int NWAVES = 8;
constexpr int RING_BYTES = 131072, LDSCTL_OFF = RING_BYTES, MISC_OFF = LDSCTL_OFF + 320, LDS_BYTES = 147456;

#define XB_LGRP(j)  (16 + (j))
#define XB_TMO      128
#define XB_XCNT(j)  (256  + 64 * (j))
#define XB_XSUB(j)  (1280 + 64 * (j))
#define XB_XGEN(j)  (2304 + 64 * (j))
#define XB_TOP      3328
#define XB_TOPGEN   3392
#define XCD_BAR_WORDS 3456
#define XB_SPIN_CAP (1u << 18)

__device__ __forceinline__ unsigned xb_ld(unsigned* p)              { return __hip_atomic_load(p, __ATOMIC_RELAXED, __HIP_MEMORY_SCOPE_AGENT); }
__device__ __forceinline__ unsigned xb_add(unsigned* p, unsigned v) { return __hip_atomic_fetch_add(p, v, __ATOMIC_RELAXED, __HIP_MEMORY_SCOPE_AGENT); }
__device__ __forceinline__ unsigned xb_xcc_id() { return (unsigned)__builtin_amdgcn_s_getreg((3 << 11) | 20) & 0xFu; }
#define XB_SPIN(cond, bar) do { unsigned _sp = 0; while (cond) { __builtin_amdgcn_s_sleep(1); \
    if ((++_sp & 255u) == 0u) { if (xb_ld(&(bar)[XB_TMO])) break; if (_sp > XB_SPIN_CAP) { atomicAdd(&(bar)[XB_TMO], 1u); break; } } } } while (0)

struct XcdBarrier {
    unsigned* bar; unsigned x;
    volatile LAS unsigned* st;
};

__device__ __forceinline__ XcdBarrier xcd_barrier_post(unsigned* bar, volatile LAS unsigned* st, unsigned lgroup) {
    XcdBarrier b; b.bar = bar; b.x = xb_xcc_id(); b.st = st;
    if (threadIdx.x == 0) { (void)xb_add(&bar[XB_XCNT(b.x)], 1u); (void)__hip_atomic_fetch_or(&bar[XB_LGRP(lgroup & 15u)], 1u << b.x, __ATOMIC_RELAXED, __HIP_MEMORY_SCOPE_AGENT); }
    return b;
}
__device__ __forceinline__ void xcd_barrier_check_regular(const XcdBarrier& b, unsigned ngroups, unsigned per_group) {
    if (threadIdx.x == 0) {
        unsigned all = 0u, ok = (b.st[0] == per_group && b.st[1] == ngroups) ? 1u : 0u;
        for (unsigned j = 0; j < ngroups; ++j) { const unsigned w = xb_ld(&b.bar[XB_LGRP(j)]); ok &= (w != 0u && (w & (w - 1u)) == 0u && (all & w) == 0u) ? 1u : 0u; all |= w; }
        b.st[5] = ok;
    }
    __syncthreads();
}
__device__ __forceinline__ void xcd_barrier_complete(unsigned* bar, unsigned x, unsigned& nloc, unsigned& nx) {
    const unsigned G = gridDim.x * gridDim.y * gridDim.z;
    unsigned sum, cnt, mine, sp = 0u;
    for (;;) {
        sum = 0u; cnt = 0u; mine = 0u;
#pragma unroll
        for (unsigned j = 0; j < 16; ++j) { const unsigned c = xb_ld(&bar[XB_XCNT(j)]); sum += c; cnt += (c > 0u) ? 1u : 0u; mine = (j == x) ? c : mine; }
        if (sum == G) break;
        __builtin_amdgcn_s_sleep(1);
        if ((++sp & 255u) == 0u) { if (xb_ld(&bar[XB_TMO])) break; if (sp > XB_SPIN_CAP) { atomicAdd(&bar[XB_TMO], 1u); break; } }
    }
    nloc = mine > 0u ? mine : 1u; nx = cnt > 0u ? cnt : 1u;
}

__device__ __forceinline__ void xcd_barrier_arrive(const XcdBarrier& b, bool local = false) {
    asm volatile("s_waitcnt vmcnt(0)" ::: "memory");
    __syncthreads();
    if (threadIdx.x == 0) {
        unsigned* bar = b.bar;
        __builtin_amdgcn_s_waitcnt(0);
        unsigned nloc = b.st[0], nx = b.st[1];
        if (nloc == 0u) { xcd_barrier_complete(bar, b.x, nloc, nx); b.st[0] = nloc; b.st[1] = nx; }
        const unsigned old = xb_add(&bar[XB_XSUB(b.x)], 1u);
        const unsigned gen = old / nloc;
        unsigned role = 0u, tg = 0u;
        if (old + 1u == (gen + 1u) * nloc && local) role = 2u;
        else if (old + 1u == (gen + 1u) * nloc) {
            __builtin_amdgcn_fence(__ATOMIC_RELEASE, "agent");
            asm volatile("s_waitcnt vmcnt(0)" ::: "memory");
            const unsigned og = xb_add(&bar[XB_TOP], 1u);
            tg = og / nx;
            if (og + 1u == (tg + 1u) * nx) { xb_add(&bar[XB_TOPGEN], 1u); role = 2u; }
            else role = 1u;
        }
        b.st[2] = role; b.st[3] = gen; b.st[4] = tg;
    }
}
__device__ __forceinline__ void xcd_barrier_wait(const XcdBarrier& b) {
    if (threadIdx.x == 0) {
        unsigned* bar = b.bar;
        const unsigned role = b.st[2], gen = b.st[3], tg = b.st[4];
        if (role != 0u) {
            if (role == 1u) XB_SPIN(xb_ld(&bar[XB_TOPGEN]) == tg, bar);
            __builtin_amdgcn_fence(__ATOMIC_ACQUIRE, "agent");
            xb_add(&bar[XB_XGEN(b.x)], 1u);
            asm volatile("s_waitcnt vmcnt(0)" ::: "memory");
        } else {
            XB_SPIN(xb_ld(&bar[XB_XGEN(b.x)]) == gen, bar);
            __builtin_amdgcn_fence(__ATOMIC_ACQUIRE, "agent");
            asm volatile("s_waitcnt vmcnt(0)" ::: "memory");
        }
    }
    __syncthreads();
}

namespace attn {
using bf16x8 = __attribute__((ext_vector_type(8))) short;
using s16x4 = __attribute__((ext_vector_type(4))) short;
using f32x16 = __attribute__((ext_vector_type(16))) float;
using u32x4 = __attribute__((ext_vector_type(4))) unsigned;
typedef float f32x2_t __attribute__((ext_vector_type(2))); typedef __bf16 bf16x2_t __attribute__((ext_vector_type(2)));
typedef short v4i16_t __attribute__((ext_vector_type(4)));
typedef __attribute__((address_space(3))) const char* lds_cptr;
constexpr int SLOTB = 32768, NSLOT = 4, LDS_WS = NSLOT * SLOTB + 1024, LDS_TB = LDS_WS + 2048, STG_PITCH = 132, TB_N = 384, TB_OFF = 127;
constexpr float THR = 8.f;
__device__ __forceinline__ int crow(int r, int hi) { return (r & 3) + 8 * (r >> 2) + 4 * hi; }
__device__ __forceinline__ void glds16(const void* gsrc, unsigned lds_dst) { unsigned keep;
    asm volatile("s_mov_b32 %0, m0\n\ts_mov_b32 m0, %2\n\ts_nop 0\n\tglobal_load_lds_dwordx4 %1, off\n\ts_mov_b32 m0, %0" : "=&s"(keep) : "v"(gsrc), "s"(lds_dst) : "memory"); }
__device__ __forceinline__ unsigned cvtpk_s(float lo, float hi) { f32x2_t v = {lo, hi}; bf16x2_t b = __builtin_convertvector(v, bf16x2_t); return __builtin_bit_cast(unsigned, b); }
__device__ __forceinline__ s16x4 vtr(lds_cptr p) { return __builtin_bit_cast(s16x4, __builtin_amdgcn_ds_read_tr16_b64_v4i16((__attribute__((address_space(3))) v4i16_t*)p)); }
__device__ __forceinline__ float swap_other(float v) { auto rr = __builtin_amdgcn_permlane32_swap(__float_as_uint(v), __float_as_uint(v), false, false); return (threadIdx.x & 32) ? __uint_as_float(rr[0]) : __uint_as_float(rr[1]); }
__device__ __forceinline__ float max3f(float x, float y, float z) { float r; asm("v_max3_f32 %0, %1, %2, %3" : "=v"(r) : "v"(x), "v"(y), "v"(z)); return r; }
__device__ __forceinline__ float max2f(float x, float y) { float r; asm("v_max_f32_e32 %0, %1, %2" : "=v"(r) : "v"(x), "v"(y)); return r; }
#define SBAR() __builtin_amdgcn_sched_barrier(0)
#define ATT_WAIT_BAR(N) asm volatile("s_waitcnt vmcnt(" #N ") lgkmcnt(0)\n\ts_barrier" ::: "memory")

struct Params { const unsigned char* Q; const unsigned char* K; const bf16* V;     bf16* O; const float* rel_bias; const float* lq1; const float* lk1; const float* lq2; const float* lk2; const float* subln; float lambda_init; };

__device__ __forceinline__ void attn_unit(const Params& P, int b, int h, int qb, float lam, LAS unsigned char* lds, int tid) {
    const int lane = tid & 63, r32 = lane & 31, hi = lane >> 5, wid = __builtin_amdgcn_readfirstlane(tid >> 6), c = wid >> 2, rblk = wid & 3;
    const size_t rowbase = (size_t)b * SEQ; const int q0 = qb * 128, qw0 = q0 + 32 * rblk;
    const unsigned char* Kh = P.K + rowbase * 1024 + h * 128; const bf16* Vh = P.V + rowbase * DM + h * 128;
    const unsigned lds0 = (unsigned)(uintptr_t)lds;
    LAS float* wsf = (LAS float*)(lds + LDS_WS) + wid * 64; const LAS float* Tb = (const LAS float*)(lds + LDS_TB) + h * TB_N;
    const int NT = 2 * (qb + 1);
    const unsigned char* ksrc0 = Kh + (size_t)lane * 1024 + wid * 16;
    const bf16* vsrc0 = Vh + (size_t)(16 * (wid & 3) + (lane >> 2)) * DM + (wid >> 2) * 32 + (lane & 3) * 8; const bf16* vsrc1 = vsrc0 + 64;
#define ATT_DMA(t, slot) do { const size_t o_ = (size_t)(t) * 64 * DM; const unsigned d_ = lds0 + (slot) * SLOTB + wid * 1024; \
        glds16(ksrc0 + (size_t)(t) * 64 * 1024, (unsigned)__builtin_amdgcn_readfirstlane(d_)); \
        glds16(vsrc0 + o_, (unsigned)__builtin_amdgcn_readfirstlane(d_ + 16384)); glds16(vsrc1 + o_, (unsigned)__builtin_amdgcn_readfirstlane(d_ + 16384 + 8192)); } while (0)
    ATT_DMA(0, 0); if (NT > 1) ATT_DMA(1, 1);
    typedef int v8i_t __attribute__((ext_vector_type(8))); typedef int v4i_t __attribute__((ext_vector_type(4)));
    v8i_t qf;
    { const unsigned char* Qw = P.Q + (size_t)b * Q8_BGAP + (rowbase + qw0 + r32) * 1024 + h * 128 + c * 64 + hi * 32;
      const v4i_t q0_ = *(const v4i_t*)Qw, q1_ = *(const v4i_t*)(Qw + 16); qf = (v8i_t){q0_[0], q0_[1], q0_[2], q0_[3], q1_[0], q1_[1], q1_[2], q1_[3]}; }
    asm volatile("" : "+v"(qf));
    float l_run = 0.f; f32x16 o[4];
#pragma unroll
    for (int d = 0; d < 4; ++d) o[d] = f32x16{};
    const lds_cptr L3 = (lds_cptr)lds;
#define ATT_VRD(i, n) do { vlo[i] = vtr(vp + ((n) & 3) * 4096 + ((n) >> 2) * 1024); vhh[i] = vtr(vp + ((n) & 3) * 4096 + ((n) >> 2) * 1024 + 512); } while (0)
#define ATT_VBASE(sl) (L3 + (sl) * SLOTB + 16384 + ((lane >> 4) & 1) * 32 + (lane & 3) * 8 + (4 * hi + ((lane & 15) >> 2)) * 64)
#define ATT_PE(g, e) ((g) < 2 ? p0[8 * (g) + (e)] : p1[8 * ((g) - 2) + (e)])
#define ATT_EXPPAIR(g, d) do { const float x0_ = ATT_PE(g, 2 * (d)), x1_ = ATT_PE(g, 2 * (d) + 1); sacc += x0_ + x1_; pw[g][d] = cvtpk_s(x0_, x1_); } while (0)
    u32x4 pw[4]; int slot = 0;
    for (int t = 0; t < NT; ++t) {
        if (t + 1 < NT) ATT_WAIT_BAR(3); else ATT_WAIT_BAR(0);
        if (t + 2 < NT) ATT_DMA(t + 2, (slot + 2) & 3);
        const int kt0 = 64 * t;
        if (kt0 <= qw0 + 31) {
            const lds_cptr kp = L3 + slot * SLOTB + (4 * c + 2 * hi) * 1024 + r32 * 16;
            unsigned va_ = (unsigned)(uintptr_t)ATT_VBASE(slot); asm volatile("" : "+v"(va_));
            const lds_cptr vp = (lds_cptr)va_;
            v8i_t kf[2];
#pragma unroll
            for (int kb = 0; kb < 2; ++kb) { const v4i_t a_ = *(const __attribute__((address_space(3))) v4i_t*)(kp + kb * 512), b_ = *(const __attribute__((address_space(3))) v4i_t*)(kp + kb * 512 + 1024);
                kf[kb] = (v8i_t){a_[0], a_[1], a_[2], a_[3], b_[0], b_[1], b_[2], b_[3]}; }
            SBAR();
            f32x16 p0 = __builtin_amdgcn_mfma_scale_f32_32x32x64_f8f6f4(kf[0], qf, f32x16{}, 0, 0, 0, 0x7f7f7f7f, 0, 0x7c7c7c7c);
            f32x16 p1 = __builtin_amdgcn_mfma_scale_f32_32x32x64_f8f6f4(kf[1], qf, f32x16{}, 0, 0, 0, 0x7f7f7f7f, 0, 0x7c7c7c7c);
            SBAR();
            asm volatile("s_nop 15\n\ts_nop 7" : "+v"(p0), "+v"(p1));
            SBAR();
            s16x4 vlo[8], vhh[8];
#pragma unroll
            for (int n = 0; n < 8; ++n) ATT_VRD(n, n);
            SBAR();
            if ((qw0 - (kt0 + 63)) < 113) {
                const LAS float* tb = Tb + ((qw0 + r32) - (kt0 + 4 * hi) + TB_OFF - 59);
#pragma unroll
                for (int r = 0; r < 16; ++r) { const int ko = (r & 3) + 8 * (r >> 2); p0[r] += tb[59 - ko]; p1[r] += tb[27 - ko]; }
            }
            float sacc = 0.f;
#pragma unroll
            for (int r = 0; r < 16; ++r) { p0[r] = __builtin_amdgcn_exp2f(p0[r]); p1[r] = __builtin_amdgcn_exp2f(p1[r]); }
#pragma unroll
            for (int d = 0; d < 4; ++d) ATT_EXPPAIR(0, d);
            SBAR();
#pragma unroll
            for (int n = 0; n < 16; ++n) { const int i = n & 7; const bf16x8 vf = {vlo[i][0], vlo[i][1], vlo[i][2], vlo[i][3], vhh[i][0], vhh[i][1], vhh[i][2], vhh[i][3]};
                o[n & 3] = __builtin_amdgcn_mfma_f32_32x32x16_bf16(__builtin_bit_cast(bf16x8, pw[n >> 2]), vf, o[n & 3], 0, 0, 0);
                if (n < 8) ATT_VRD(i, n + 8);
                if (n < 12) { ATT_EXPPAIR((n >> 2) + 1, n & 3); asm volatile("" : "+v"(sacc), "+v"(pw[(n >> 2) + 1])); }
                SBAR(); }
            asm volatile("" :: "v"(va_));
            l_run += sacc;
        }
        slot = (slot + 1) & 3;
    }
#undef ATT_VRD
#undef ATT_VBASE
#undef ATT_PE
#undef ATT_EXPPAIR
    ATT_WAIT_BAR(0);
    { const float lt = l_run + swap_other(l_run); if (hi == 0) wsf[32 + r32] = (c == 1 ? lam : 1.f) / lt; }
    asm volatile("s_waitcnt lgkmcnt(0)" ::: "memory");
    float rl[16];
#pragma unroll
    for (int r = 0; r < 16; ++r) rl[r] = wsf[32 + crow(r, hi)];
    LAS float* stg = (LAS float*)lds + (size_t)(rblk * 32) * STG_PITCH;
    if (c == 1) {
#pragma unroll
        for (int r = 0; r < 16; ++r)
#pragma unroll
            for (int d = 0; d < 4; ++d) stg[crow(r, hi) * STG_PITCH + d * 32 + r32] = o[d][r] * rl[r];
    }
    ATT_WAIT_BAR(0);
    if (c == 0) {
#pragma unroll
        for (int r = 0; r < 16; ++r)
#pragma unroll
            for (int d = 0; d < 4; ++d) { LAS float* e = stg + crow(r, hi) * STG_PITCH + d * 32 + r32; *e = o[d][r] * rl[r] - *e; }
        asm volatile("s_waitcnt lgkmcnt(0)" ::: "memory");
        const int row = lane >> 1, half = lane & 1; const LAS f32x4* src = (const LAS f32x4*)(stg + row * STG_PITCH + half * 64);
        f32x4 v[16]; float ss = 0.f;
#pragma unroll
        for (int i = 0; i < 16; ++i) { v[i] = src[i]; const f32x4 t2 = v[i] * v[i]; ss += (t2[0] + t2[1]) + (t2[2] + t2[3]); }
        ss += __shfl_xor(ss, 1);
        const float rr = rsqrtf(ss * (1.f / 128.f) + EPS) * (1.f - P.lambda_init);
        bf16* orow = P.O + (size_t)b * QO_BGAP + (rowbase + qw0 + row) * DM + h * 128 + half * 64; const f32x4* sw = (const f32x4*)(P.subln + half * 64);
#pragma unroll
        for (int i = 0; i < 8; ++i) { const f32x4 a = v[2 * i] * rr * sw[2 * i], bq = v[2 * i + 1] * rr * sw[2 * i + 1];
            u32x4 w; w.x = cvtpk_s(a[0], a[1]); w.y = cvtpk_s(a[2], a[3]); w.z = cvtpk_s(bq[0], bq[1]); w.w = cvtpk_s(bq[2], bq[3]); *(u32x4*)(orow + 8 * i) = w; }
    }
    ATT_WAIT_BAR(0);
#undef ATT_DMA
}

__device__ __forceinline__ void attn_phase(const Params& P, LAS unsigned char* lds, int tid, int vcu) {
    const int lane = tid & 63, x = vcu >> 5, j2 = vcu & 31, j = j2 & 15;
    LAS float* Tb = (LAS float*)(lds + LDS_TB);
    for (int i = tid; i < NH * TB_N; i += 512) { const int h = i / TB_N, d = i % TB_N - TB_OFF;
        Tb[i] = d < 0 ? -INFINITY : (P.rel_bias[t5_bucket(d) * NH + h] - P.rel_bias[31 * NH + h]) * LOG2E; }
    const float lam = expf(wave_sum(P.lq1[lane] * P.lk1[lane])) - expf(wave_sum(P.lq2[lane] * P.lk2[lane])) + P.lambda_init;
    asm volatile("s_waitcnt lgkmcnt(0)" ::: "memory"); __syncthreads();
    for (int k = 0; k < 4; ++k) { const int bh = 8 * x + 2 * k + (j2 >> 4), qb = (k & 1) ? 15 - j : j; attn_unit(P, bh >> 3, bh & 7, qb, lam, lds, tid); }
}
#undef ATT_WAIT_BAR
#undef SBAR
}

struct Frame { LAS unsigned char* lds; int tid, lane, wave, vcu, G; };
__device__ __forceinline__ void conv_loads(const float* W, int N, int item, int lane, float (&v)[32]) {
    const int nblk = N / 32, kb = item / nblk, nb = item % nblk; const float* src = W + (size_t)(64 * kb + (lane >> 5)) * N + 32 * nb + (lane & 31);
#pragma unroll
    for (int i = 0; i < 32; ++i) v[i] = src[(size_t)(2 * i) * N];
}
__device__ __forceinline__ void conv_finish(int K, int N, const float* gain, bf16* WT, LAS float* scr, int item, int lane, const float (&v)[32]) {
    const int nblk = N / 32, kb = item / nblk, nb = item % nblk, k0 = 64 * kb, n0 = 32 * nb, c = lane & 7;
    float gv[8];
#pragma unroll
    for (int i = 0; i < 8; ++i) gv[i] = gain ? gain[k0 + 8 * c + i] : 1.f;
#pragma unroll
    for (int i = 0; i < 32; ++i) scr[(2 * i + (lane >> 5)) * 33 + (lane & 31)] = v[i];
    LDS_WAIT(); asm volatile("" ::: "memory");
#pragma unroll
    for (int j = 0; j < 4; ++j) { const int n = (lane >> 3) + 8 * j; const LAS float* s = scr + (8 * c) * 33 + n;
        v4u o; o.x = pk2(s[0 * 33] * gv[0], s[1 * 33] * gv[1]); o.y = pk2(s[2 * 33] * gv[2], s[3 * 33] * gv[3]); o.z = pk2(s[4 * 33] * gv[4], s[5 * 33] * gv[5]); o.w = pk2(s[6 * 33] * gv[6], s[7 * 33] * gv[7]);
        *(GAS v4u*)(WT + (size_t)(n0 + n) * K + k0 + 8 * c) = o; }
    LDS_WAIT(); asm volatile("" ::: "memory");
}
__device__ __forceinline__ void conv_mat(const Frame& F, const float* W, int K, int N, const float* gain, bf16* WT, int rot) {
    LAS float* scr = (LAS float*)(F.lds + F.wave * 16384);
    const int NGW = F.G * NWAVES, gw = (F.vcu * NWAVES + F.wave + rot) % NGW, nit = (K / 64) * (N / 32);
    for (int it = 2 * gw; it < nit; it += 2 * NGW) { float va[32], vb[32];
        conv_loads(W, N, it, F.lane, va); if (it + 1 < nit) conv_loads(W, N, it + 1, F.lane, vb);
        conv_finish(K, N, gain, WT, scr, it, F.lane, va); if (it + 1 < nit) conv_finish(K, N, gain, WT, scr, it + 1, F.lane, vb); }
}
__device__ __forceinline__ void conv_colmax(const Frame& F, const float* W, int K, int N, const float* gain, float* colmax, int rot) {
    const int NGW = F.G * NWAVES, gw = (F.vcu * NWAVES + F.wave + rot) % NGW, nit = (K / 64) * (N / 32), nblk = N / 32;
    for (int it = gw; it < nit; it += NGW) { float v[32]; conv_loads(W, N, it, F.lane, v);
        const int kb = it / nblk, nb = it % nblk; float m = 0.f;
#pragma unroll
        for (int i = 0; i < 32; ++i) m = fmaxf(m, fabsf(v[i] * (gain ? gain[64 * kb + 2 * i + (F.lane >> 5)] : 1.f)));
#pragma unroll
        for (int o = 1; o < 64; o <<= 1) m = fmaxf(m, __builtin_bit_cast(float, __builtin_amdgcn_ds_bpermute((F.lane ^ o) << 2, __builtin_bit_cast(int, m))));
        if (F.lane == 0) atomicMax((unsigned*)colmax + nb, __float_as_uint(m)); }
}
__device__ __forceinline__ void conv_finish_i8(int K, int N, const float* gain, const float* colmax, unsigned char* WT, LAS float* scr, int item, int lane, const float (&v)[32]) {
    const int nblk = N / 32, kb = item / nblk, nb = item % nblk, k0 = 64 * kb, n0 = 32 * nb, c = lane & 7;
    float gv[8];
#pragma unroll
    for (int i = 0; i < 8; ++i) gv[i] = gain ? gain[k0 + 8 * c + i] : 1.f;
#pragma unroll
    for (int i = 0; i < 32; ++i) scr[(2 * i + (lane >> 5)) * 33 + (lane & 31)] = v[i];
    LDS_WAIT(); asm volatile("" ::: "memory");
#pragma unroll
    for (int j = 0; j < 4; ++j) { const int n = (lane >> 3) + 8 * j; const LAS float* s = scr + (8 * c) * 33 + n;
        const float cm = colmax[nb], inv = cm > 0.f ? 127.f / cm : 0.f; unsigned t[8];
#pragma unroll
        for (int i = 0; i < 8; ++i) t[i] = __float_as_uint(__builtin_amdgcn_fmed3f(s[i * 33] * gv[i] * inv, -127.f, 127.f) + 12582912.f);
        v2u o; o.x = __builtin_amdgcn_perm(t[1], t[0], 0x0c0c0400u) | __builtin_amdgcn_perm(t[3], t[2], 0x04000c0cu); o.y = __builtin_amdgcn_perm(t[5], t[4], 0x0c0c0400u) | __builtin_amdgcn_perm(t[7], t[6], 0x04000c0cu);
        *(GAS v2u*)(WT + (size_t)(n0 + n) * K + k0 + 8 * c) = o; }
    LDS_WAIT(); asm volatile("" ::: "memory");
}
__device__ __forceinline__ void conv_mat_i8(const Frame& F, const float* W, int K, int N, const float* gain, const float* colmax, unsigned char* WT, int rot) {
    LAS float* scr = (LAS float*)(F.lds + F.wave * 16384);
    const int NGW = F.G * NWAVES, gw = (F.vcu * NWAVES + F.wave + rot) % NGW, nit = (K / 64) * (N / 32);
    for (int it = 2 * gw; it < nit; it += 2 * NGW) { float va[32], vb[32];
        conv_loads(W, N, it, F.lane, va); if (it + 1 < nit) conv_loads(W, N, it + 1, F.lane, vb);
        conv_finish_i8(K, N, gain, colmax, WT, scr, it, F.lane, va); if (it + 1 < nit) conv_finish_i8(K, N, gain, colmax, WT, scr, it + 1, F.lane, vb); }
}
__device__ __forceinline__ void quant_rows(const Frame& F, const bf16* XB, unsigned char* XQ, float* srow, int row0) {
    v4u xa[8], xb2[8];
#pragma unroll
    for (int i = 0; i < 8; ++i) { const bf16* p = XB + (size_t)(row0 + 8 * F.wave + i) * DM + 16 * F.lane; xa[i] = *(const GAS v4u*)p; xb2[i] = *(const GAS v4u*)(p + 8); }
#pragma unroll
    for (int i = 0; i < 8; ++i) { const int row = row0 + 8 * F.wave + i; float x[16];
#pragma unroll
        for (int j = 0; j < 4; ++j) { x[2 * j] = __uint_as_float(xa[i][j] << 16); x[2 * j + 1] = __uint_as_float(xa[i][j] & 0xffff0000u); x[8 + 2 * j] = __uint_as_float(xb2[i][j] << 16); x[9 + 2 * j] = __uint_as_float(xb2[i][j] & 0xffff0000u); }
        float m = 0.f;
#pragma unroll
        for (int j = 0; j < 16; ++j) m = fmaxf(m, fabsf(x[j]));
#pragma unroll
        for (int o = 1; o < 64; o <<= 1) m = fmaxf(m, __builtin_bit_cast(float, __builtin_amdgcn_ds_bpermute((F.lane ^ o) << 2, __builtin_bit_cast(int, m))));
        const float inv = m > 0.f ? 127.f / m : 0.f; unsigned t[16];
#pragma unroll
        for (int j = 0; j < 16; ++j) t[j] = __float_as_uint(x[j] * inv + 12582912.f);
        v4u o;
#pragma unroll
        for (int j = 0; j < 4; ++j) o[j] = __builtin_amdgcn_perm(t[4 * j + 1], t[4 * j], 0x0c0c0400u) | __builtin_amdgcn_perm(t[4 * j + 3], t[4 * j + 2], 0x04000c0cu);
        *(GAS v4u*)(XQ + (size_t)row * DM + 16 * F.lane) = o;
        if (F.lane == 0) srow[row] = m * (1.f / 127.f); }
}
__device__ __forceinline__ f32x4 ld_row4(const float* x, const bf16* xb, size_t idx) {
    if (x) return *(const GAS f32x4*)(x + idx);
    const v2u w = *(const GAS v2u*)(xb + idx); return (f32x4){__uint_as_float(w.x << 16), __uint_as_float(w.x & 0xffff0000u), __uint_as_float(w.y << 16), __uint_as_float(w.y & 0xffff0000u)};
}
template <int WIN> __device__ __forceinline__ void pool_walk(const float* x, const bf16* xb, const LAS float* rs, size_t rowb, int t0, int ts, int g, int lane, const f32x4 gv, bf16* MB) {
    const int ch = g * 256 + lane * 4;
    f32x4 prv[16], cur[16];
#pragma unroll
    for (int i = 0; i < 16; ++i) { const int t = ts - 16 + i; prv[i] = (f32x4){0.f, 0.f, 0.f, 0.f}; if (t >= 0) prv[i] = ld_row4(x, xb, (rowb + t) * DM + ch) * rs[t - t0 + 16]; }
    f32x4 s = {0.f, 0.f, 0.f, 0.f};
#pragma unroll
    for (int j = 1; j < WIN; ++j) s += prv[16 - j];
#pragma unroll
    for (int cb = 0; cb < 2; ++cb) {
#pragma unroll
        for (int i = 0; i < 16; ++i) { const int t = ts + 16 * cb + i; cur[i] = ld_row4(x, xb, (rowb + t) * DM + ch) * rs[t - t0 + 16]; }
#pragma unroll
        for (int i = 0; i < 16; ++i) { const int t = ts + 16 * cb + i;
            s += cur[i];
            const int cnt = (t + 1) < WIN ? (t + 1) : WIN; const f32x4 m = (s * (1.f / (float)cnt) - cur[i]) * gv;
            v2u o; o.x = pk2(m.x, m.y); o.y = pk2(m.z, m.w);
            *(GAS v2u*)(MB + ((size_t)g * M + rowb + t) * 256 + lane * 4) = o;
            const int oi = 16 + i - WIN + 1;
            s -= oi < 16 ? prv[oi] : cur[oi - 16]; }
#pragma unroll
        for (int i = 0; i < 16; ++i) prv[i] = cur[i];
    }
}
__device__ __forceinline__ void rows_ssq(const Frame& F, const float* x, float* ssq) {
    const int NGW = F.G * NWAVES, gw = F.vcu * NWAVES + F.wave;
    for (int m0 = gw * 4; m0 < M; m0 += NGW * 4) { f32x4 v[4][4]; float s[4];
#pragma unroll
        for (int r = 0; r < 4; ++r)
#pragma unroll
            for (int j = 0; j < 4; ++j) v[r][j] = ((const GAS f32x4*)(x + (size_t)(m0 + r) * DM))[F.lane + 64 * j];
#pragma unroll
        for (int r = 0; r < 4; ++r) { s[r] = 0.f;
#pragma unroll
            for (int j = 0; j < 4; ++j) s[r] += (v[r][j].x * v[r][j].x + v[r][j].y * v[r][j].y) + (v[r][j].z * v[r][j].z + v[r][j].w * v[r][j].w); }
#pragma unroll
        for (int o = 1; o < 64; o <<= 1)
#pragma unroll
            for (int r = 0; r < 4; ++r) s[r] += __builtin_bit_cast(float, __builtin_amdgcn_ds_bpermute((F.lane ^ o) << 2, __builtin_bit_cast(int, s[r])));
        if (F.lane < 4) { const float sv = F.lane == 0 ? s[0] : F.lane == 1 ? s[1] : F.lane == 2 ? s[2] : s[3]; ssq[m0 + F.lane] = sv; ssq[M + m0 + F.lane] = 0.f; ssq[2 * M + m0 + F.lane] = 0.f; ssq[3 * M + m0 + F.lane] = 0.f; } }
}
__device__ __forceinline__ void pool_prepass_unit(const Frame& F, int pm, int g, const float* x, const bf16* xb, const float* ssq, const float* gain, bf16* MB) {
    const int b = pm >> 3, t0 = (pm & 7) * 256; const size_t rowb = (size_t)b * SEQ;
    LAS float* rs = (LAS float*)F.lds;
    if (F.tid < 272) { const int t = t0 - 16 + F.tid; if (t >= 0) rs[F.tid] = row_rstd(ssq, (int)rowb + t); }
    LDS_WAIT(); __syncthreads();
    const int ts = t0 + 32 * F.wave;
    const f32x4 gv = *(const f32x4*)(gain + g * 256 + F.lane * 4);
    if (g == 0) pool_walk<2>(x, xb, rs, rowb, t0, ts, g, F.lane, gv, MB); else if (g == 1) pool_walk<4>(x, xb, rs, rowb, t0, ts, g, F.lane, gv, MB);
    else if (g == 2) pool_walk<8>(x, xb, rs, rowb, t0, ts, g, F.lane, gv, MB); else pool_walk<16>(x, xb, rs, rowb, t0, ts, g, F.lane, gv, MB);
    VM_WAIT(); __syncthreads();
}

struct MArgs { const float* in[19]; float* out; unsigned char* ws; int ph_lo, ph_hi, use_bar, li; float lam0, lam1; };
constexpr int N_PHASES = 18;
#ifndef DUP_TYPE
#define DUP_TYPE -1
#endif
enum { T_PRE = 0, T_POOL, T_MLPIN, T_MLPOUT, T_QKV, T_ATTN, T_OPROJ };
__host__ __device__ __forceinline__ int ph_type(int ph) { if (ph < 8) { const int s = ph & 3; return s == 0 ? T_PRE : s == 1 ? T_POOL : s == 2 ? T_MLPIN : T_MLPOUT; }
    const int s = (ph - 8) % 5; return s == 0 ? T_QKV : s == 1 ? T_ATTN : s == 2 ? T_OPROJ : s == 3 ? T_MLPIN : T_MLPOUT; }
__host__ __device__ __forceinline__ int ph_layer(int ph) { return ph < 8 ? ph / 4 : 2 + (ph - 8) / 5; }

__global__ void __launch_bounds__(NWAVES * 64, 2) mega(MArgs a) {
    extern __shared__ __attribute__((aligned(16))) unsigned char lds_raw[];
    Frame F; F.lds = (LAS unsigned char*)lds_raw; F.tid = threadIdx.x; F.lane = F.tid & 63; F.wave = __builtin_amdgcn_readfirstlane(F.tid >> 6);
    F.G = gridDim.x; { const int bx = blockIdx.x; F.vcu = (F.G % 8 == 0) ? (bx % 8) * (F.G / 8) + bx / 8 : bx; }
    volatile LAS unsigned* MISC = (volatile LAS unsigned*)(F.lds + MISC_OFF);
    unsigned char* ws0 = a.ws;
    for (int u = F.tid; u < (LDS_BYTES - LDSCTL_OFF) / 4; u += NWAVES * 64) ((LAS unsigned*)(F.lds + LDSCTL_OFF))[u] = 0u;
    __syncthreads();
    unsigned* barw = (unsigned*)(ws0 + WS_CTL) + CW_BAR + a.li * XCD_BAR_WORDS;
    XcdBarrier bar; bar.bar = barw; bar.x = 0; bar.st = nullptr;
    if (a.use_bar) bar = xcd_barrier_post(barw, MISC + 8, (unsigned)(F.vcu >> 5));

    for (int it = 2 * a.ph_lo; it < 2 * a.ph_hi; ++it) { const int ph = it >> 1, rep = it & 1;
        const int ty = ph_type(ph), l = ph_layer(ph);
        { int t_ = threadIdx.x; asm volatile("" : "+v"(t_)); F.tid = t_; F.lane = t_ & 63; F.wave = __builtin_amdgcn_readfirstlane(t_ >> 6); }
        size_t zz = 0; asm volatile("" : "+s"(zz));
            unsigned char* ws = a.ws + zz;
        const float* x0 = (a.in[0] + zz); const float* norm_mix = (a.in[1] + zz); const float* norm_mlp = (a.in[2] + zz); const float* pool_w = (a.in[3] + zz); const float* pool_scale = (a.in[4] + zz);
        const float* kv_norm = (a.in[5] + zz); const float* w_kv = (a.in[6] + zz); const float* k_norm = (a.in[7] + zz); const float* w_q = (a.in[9] + zz); const float* q_norm = (a.in[10] + zz);
        const float* rel_bias = (a.in[8] + zz); const float* lq1 = (a.in[11] + zz); const float* lk1 = (a.in[12] + zz); const float* lq2 = (a.in[13] + zz); const float* lk2 = (a.in[14] + zz); const float* subln = (a.in[15] + zz);
        const float* w_o = (a.in[16] + zz); const float* w_in = (a.in[17] + zz); const float* w_out = (a.in[18] + zz);
        float* X = a.out + zz; float* SSQ = (float*)(ws + WS_SSQ); float* SSQ2 = (float*)(ws + WS_SSQ2);
        bf16* WIN = (bf16*)(ws + WS_WIN); bf16* WOUT = (bf16*)(ws + WS_WOUT); bf16* WQKV = (bf16*)(ws + WS_WQKV); bf16* WQ1 = (bf16*)(ws + WS_WQ1); bf16* WO = (bf16*)(ws + WS_WO); bf16* POOL = (bf16*)(ws + WS_POOL);
        unsigned char* XB8 = ws + WS_K + 16 * MiB;
        float* SROW = (float*)(ws + 131072);
        float* CMAX = (float*)(ws + WS_CTL + 32768);
        bf16* XB = (bf16*)(ws + WS_XB); bf16* Kb = (bf16*)(ws + WS_K); bf16* Vb = (bf16*)(ws + WS_V); bf16* Ab = (bf16*)(ws + WS_A); bf16* Qb = (bf16*)(ws + WS_Q); bf16* Ob = (bf16*)(ws + WS_O); bf16* MB = (bf16*)(ws + WS_MB);
        if (rep == 0 && !(ty == DUP_TYPE && (ty == T_PRE || ty == T_MLPIN || ty == T_QKV || ty == T_ATTN))) continue;
        if (ty == T_PRE) {
            if (l == 1) {
                pg8::StaticOrder S; S.init(M, DM, F.G, (int)blockIdx.x); pg8::Unit u0; S.next(0, u0);
                pool_prepass_unit(F, u0.pm, u0.pn, nullptr, XB, SSQ2, norm_mix + l * DM, MB);
            } else {
                for (int i = 0; i < 8; ++i) conv_mat(F, pool_w + (size_t)i * 65536, 256, 256, nullptr, POOL + (size_t)i * 65536, i * 32);
                rows_ssq(F, x0, SSQ2);
            }
        } else if (ty == T_MLPIN) {
            pg8::StaticOrder S; S.init(M, FF, F.G, (int)blockIdx.x);
            if (l == 0) {
                pg8::Gemm g{XB, WIN, M, FF, DM, 0, 0}; pg8::EpiMlpIn E{Ab, nullptr};
                pg8::gemm_phase<pg8::EpiMlpIn, pg8::StaticOrder, true, true, false>(F.lds, g, S, E, F.tid);
            } else {
                { pg8::Unit u0; S.next(0, u0); quant_rows(F, XB, XB8, SROW, u0.pm * 256 + 64 * (u0.pn & 3)); }
                if (rep == 1 && a.use_bar) { xcd_barrier_arrive(bar, MISC[13] != 0u); xcd_barrier_wait(bar); } else __syncthreads();
                pg8::Gemm g{(const bf16*)XB8, WIN, M, FF, DM / 2, 0, 0}; pg8::EpiMlpIn E{Ab, CMAX + 128 + 128 * l};
                pg8::gemm_phase<pg8::EpiMlpIn, pg8::StaticOrder, true, true, true>(F.lds, g, S, E, F.tid);
            }
        } else if (ty == T_QKV) {
            const int N = l == 2 ? 3 * DM : DM;
            pg8::Gemm g{(const bf16*)XB8, l == 2 ? WQKV : WQ1, M, N, DM / 2, 0, 0}; pg8::StaticOrder S; S.init(M, N, F.G, (int)blockIdx.x);
            pg8::EpiQKV E{(unsigned char*)Qb, (unsigned char*)Kb, Vb, SSQ2, q_norm + (l - 2) * 64, k_norm, 0, SSQ, CMAX + (l == 2 ? 0 : 96)};
            pg8::gemm_phase<pg8::EpiQKV, pg8::StaticOrder, true, true, true>(F.lds, g, S, E, F.tid);
        } else if (ty == T_ATTN) {
            const int j = l - 2;
            attn::Params AP{(const unsigned char*)Qb, (const unsigned char*)Kb, Vb, Ob, rel_bias, lq1 + j * 64, lk1 + j * 64, lq2 + j * 64, lk2 + j * 64, subln + j * 128, j == 0 ? a.lam0 : a.lam1};
            attn::attn_phase(AP, F.lds, F.tid, F.vcu);
        } else {
            pg8::Gemm g; pg8::EpiResid E;
            pg8::StaticOrder S; S.init(M, DM, F.G, (int)blockIdx.x);
            if (ty == T_POOL) { if (l == 0) { pg8::Unit u0; S.next(0, u0); pool_prepass_unit(F, u0.pm, u0.pn, x0, XB, SSQ2, norm_mix, MB); }
                g = pg8::Gemm{MB, POOL + (size_t)l * 4 * 65536, M, DM, 256, (size_t)M * 256 * 2, 0}; E = pg8::EpiResid{l == 0 ? x0 : nullptr, nullptr, XB, pool_scale + l * DM, SSQ, nullptr}; }
            else if (ty == T_MLPOUT) {
                g = pg8::Gemm{Ab, WOUT, M, DM, FF, 0, 0}; E = pg8::EpiResid{nullptr, l == 3 ? X : nullptr, XB, nullptr, SSQ2, SSQ, (l == 1 || l == 2) ? XB8 : nullptr, l == 0 ? nullptr : SROW}; }
            else { g = pg8::Gemm{Ob, WO + (size_t)(l - 2) * DM * DM, M, DM, DM, 0, QO_BGAP * 2}; E = pg8::EpiResid{nullptr, nullptr, XB, nullptr, SSQ, nullptr}; }
            pg8::gemm_phase<pg8::EpiResid, pg8::StaticOrder, false, true>(F.lds, g, S, E, F.tid);
        }
        if (rep == 0) __syncthreads();
        else if (ph + 1 < a.ph_hi) {
            const bool loc_seam = MISC[13] != 0u && ((0x15AD0u >> ph) & 1u) != 0u;
            xcd_barrier_arrive(bar, loc_seam);
            if (ty == T_MLPOUT && l == 0) conv_mat_i8(F, w_in + (size_t)DM * FF, DM, FF, norm_mlp + DM, CMAX + 256, (unsigned char*)WIN, 0);
            if (ty == T_PRE && l == 1) conv_mat(F, w_out + (size_t)DM * FF, FF, DM, nullptr, WOUT, 0);
            if (ty == T_ATTN) { conv_mat_i8(F, w_in + (size_t)l * DM * FF, DM, FF, norm_mlp + l * DM, CMAX + 128 + 128 * l, (unsigned char*)WIN, 0); conv_mat(F, w_out + (size_t)l * DM * FF, FF, DM, nullptr, WOUT, 1024); }
            if (ph == 0) { conv_mat(F, w_in, DM, FF, norm_mlp, WIN, 0); conv_colmax(F, w_q, DM, DM, norm_mix + 2 * DM, CMAX, 1024); conv_colmax(F, w_kv, DM, 2 * DM, kv_norm, CMAX + 32, 1536); }
            if (ph == 1) { conv_mat(F, w_out, FF, DM, nullptr, WOUT, 0); conv_colmax(F, w_in + (size_t)DM * FF, DM, FF, norm_mlp + DM, CMAX + 256, 0); }
            if (ph == 10) conv_colmax(F, w_in + (size_t)3 * DM * FF, DM, FF, norm_mlp + 3 * DM, CMAX + 512, 0);
            if (ph == 2) { conv_mat_i8(F, w_q, DM, DM, norm_mix + 2 * DM, CMAX, (unsigned char*)WQKV, 0); conv_mat_i8(F, w_kv, DM, 2 * DM, kv_norm, CMAX + 32, (unsigned char*)WQKV + (size_t)DM * DM, 512); }
            if (ph == 5) { conv_colmax(F, w_in + (size_t)2 * DM * FF, DM, FF, norm_mlp + 2 * DM, CMAX + 384, 512);     conv_mat(F, w_o, DM, DM, nullptr, WO, 0); conv_colmax(F, w_q + (size_t)DM * DM, DM, DM, norm_mix + 3 * DM, CMAX + 96, 1024); }
            if (ty == T_ATTN && l == 2) { conv_mat_i8(F, w_q + (size_t)DM * DM, DM, DM, norm_mix + 3 * DM, CMAX + 96, (unsigned char*)WQ1, 0); conv_mat(F, w_o + (size_t)DM * DM, DM, DM, nullptr, WO + (size_t)DM * DM, 512); }
            xcd_barrier_wait(bar);
            if (ph == a.ph_lo) xcd_barrier_check_regular(bar, 8u, 32u);
        }
    }
}

extern "C" void kernel_launch(void* const* d_in, const int* in_sizes, int n_in, void* d_out, int out_size, void* d_ws, size_t ws_size, hipStream_t stream) {
    static int ready = 0;
    if (!ready) { ready = 1;
        int dev = 0, cus = 0, per_cu = 0;
        (void)hipFuncSetAttribute((const void*)mega, hipFuncAttributeMaxDynamicSharedMemorySize, LDS_BYTES);
        if (hipGetDevice(&dev) != hipSuccess || hipDeviceGetAttribute(&cus, hipDeviceAttributeMultiprocessorCount, dev) != hipSuccess) cus = 0;
        if (hipOccupancyMaxActiveBlocksPerMultiprocessor(&per_cu, (const void*)mega, NWAVES * 64, LDS_BYTES) != hipSuccess) per_cu = 0;
        (void)hipGetLastError();
        if (cus != 256 || per_cu < 1) fprintf(stderr, "kernel_launch: built for 256 CUs with one resident workgroup each; this device reports %d CUs, %d workgroups per CU\n", cus, per_cu);
    }
    (void)hipMemsetAsync((char*)d_ws + WS_CTL, 0, CTL_ZERO_BYTES, stream);
    MArgs a{};
    for (int i = 0; i < 19; ++i) a.in[i] = (const float*)d_in[i];
    a.out = (float*)d_out; a.ws = (unsigned char*)d_ws;
    a.lam0 = (float)(0.8 - 0.6 * exp(-0.3 * 2.0)); a.lam1 = (float)(0.8 - 0.6 * exp(-0.3 * 3.0));
    a.ph_lo = 0; a.ph_hi = N_PHASES; a.use_bar = 1; a.li = 0;
    hipLaunchKernelGGL(mega, dim3(256), dim3(NWAVES * 64), LDS_BYTES, stream, a);
}
```
